# Optimizing an MI355X kernel written in HIP

```python
import math
import jax, jax.numpy as jnp
from jax import lax
import numpy as np

D_MODEL = 1024
BATCH = 8
SEQ = 2048
DEPTH = 2

GRID_W = 64
Q_BLOCK = 128
HEAD_DIM = 64
ROPE_THETA = 10000.0
EPS = 1e-6
NEG_INF = -1e30

A_HEADS = 8
A_KV_HEADS = 2

B_HEADS = 8
B_BRANCHES = ((128, 1), (512, 4), (2048, 16))
NUM_BUCKETS = 32
REL_MAX_DISTANCE = 1024

C_HEADS = 16
C_Q_RANK = 256
C_KV_RANK = 128
C_NOPE_DIM = 64
C_ROPE_DIM = 32
C_V_DIM = 64

D_FF = 4 * D_MODEL

A_Q_W = A_HEADS * HEAD_DIM
A_KV_W = A_KV_HEADS * HEAD_DIM
B_W = B_HEADS * HEAD_DIM
AB_IN_W = A_Q_W + 2 * A_KV_W + 3 * B_W
AB_OUT_IN = A_Q_W + B_W
C_DOWN_W = C_Q_RANK + C_KV_RANK + C_ROPE_DIM
C_QK_DIM = C_NOPE_DIM + C_ROPE_DIM
C_OUT_IN = C_HEADS * C_V_DIM
N_EVEN = (DEPTH + 1) // 2
N_ODD = DEPTH // 2

kernel_name = "hybrid_gqa_dilated_mla_encoder"


def rms_norm(x, g):
    xf = x.astype(jnp.float32)
    y = xf * lax.rsqrt(jnp.mean(xf * xf, axis=-1, keepdims=True) + EPS)
    return (y * g.astype(jnp.float32)).astype(x.dtype)


def rope_angles(pos, dim):
    inv_freq = ROPE_THETA ** (-jnp.arange(0, dim, 2, dtype=jnp.float32) / dim)
    return pos.astype(jnp.float32)[:, None] * inv_freq[None, :]


def apply_rope(x, cos, sin):
    xf = x.astype(jnp.float32)
    half = x.shape[-1] // 2
    x1, x2 = xf[..., :half], xf[..., half:]
    out = jnp.concatenate([x1 * cos - x2 * sin, x2 * cos + x1 * sin], axis=-1)
    return out.astype(x.dtype)


def unblock(o):
    nb, b, q = o.shape[:3]
    return jnp.moveaxis(o, 0, 1).reshape((b, nb * q) + o.shape[3:])


def t5_bucket(rel):
    nb = NUM_BUCKETS // 2
    max_exact = nb // 2
    base = jnp.where(rel > 0, nb, 0)
    n = jnp.abs(rel)
    nf = jnp.maximum(n, 1).astype(jnp.float32)
    large = max_exact + (jnp.log(nf / max_exact) / math.log(REL_MAX_DISTANCE / max_exact)
                         * (nb - max_exact)).astype(jnp.int32)
    large = jnp.minimum(large, nb - 1)
    return base + jnp.where(n < max_exact, n, large)


def gqa_attention(q, k, v):
    b, s = q.shape[:2]
    rep = A_HEADS // A_KV_HEADS
    q = q.reshape(b, s, A_KV_HEADS, rep, HEAD_DIM)
    scale = HEAD_DIM ** -0.5

    def block(i):
        qb = lax.dynamic_slice_in_dim(q, i * Q_BLOCK, Q_BLOCK, axis=1)
        logits = jnp.einsum('bqgrd,bkgd->bgrqk', qb, k).astype(jnp.float32) * scale
        p = jax.nn.softmax(logits, axis=-1).astype(v.dtype)
        return jnp.einsum('bgrqk,bkgd->bqgrd', p, v)

    o = unblock(lax.map(block, jnp.arange(s // Q_BLOCK)))
    return o.reshape(b, s, A_HEADS * HEAD_DIM)


def dilated_attention(q, k, v, rel_bias):
    b, s = q.shape[:2]
    scale = HEAD_DIM ** -0.5
    pad = max((w // (2 * d)) * d for w, d in B_BRANCHES)
    kp = jnp.pad(k, ((0, 0), (pad, pad), (0, 0), (0, 0)))
    vp = jnp.pad(v, ((0, 0), (pad, pad), (0, 0), (0, 0)))
    offsets, biases = [], []
    for w, d in B_BRANCHES:
        n_side = w // (2 * d)
        off = jnp.arange(-n_side, n_side + 1, dtype=jnp.int32) * d
        offsets.append(off)
        biases.append(rel_bias[t5_bucket(off)].astype(jnp.float32).T)

    def block(i):
        t = i * Q_BLOCK + jnp.arange(Q_BLOCK, dtype=jnp.int32)
        qb = lax.dynamic_slice_in_dim(q, i * Q_BLOCK, Q_BLOCK, axis=1)
        outs, lses = [], []
        for off, bias in zip(offsets, biases):
            pos = t[:, None] + off[None, :]
            valid = (pos >= 0) & (pos < s)
            kg = jnp.take(kp, pos + pad, axis=1)
            vg = jnp.take(vp, pos + pad, axis=1)
            logits = jnp.einsum('bqhd,bqkhd->bhqk', qb, kg).astype(jnp.float32) * scale
            logits = jnp.where(valid[None, None], logits + bias[None, :, None, :], NEG_INF)
            m = jnp.max(logits, axis=-1, keepdims=True)
            p = jnp.exp(logits - m)
            l = jnp.sum(p, axis=-1, keepdims=True)
            o = jnp.einsum('bhqk,bqkhd->bqhd', (p / l).astype(vg.dtype), vg)
            outs.append(o.astype(jnp.float32))
            lses.append((m + jnp.log(l))[..., 0])
        wts = jax.nn.softmax(jnp.stack(lses, axis=0), axis=0)
        wts = jnp.transpose(wts, (0, 1, 3, 2))[..., None]
        return jnp.sum(jnp.stack(outs, axis=0) * wts, axis=0).astype(q.dtype)

    o = unblock(lax.map(block, jnp.arange(s // Q_BLOCK)))
    return o.reshape(b, s, B_HEADS * HEAD_DIM)


def mla_attention(xn, w_down, q_norm_g, kv_norm_g, w_uq, w_ukv, cos, sin):
    b, s = xn.shape[:2]
    h = xn @ w_down
    c_q, c_kv, k_r = jnp.split(h, [C_Q_RANK, C_Q_RANK + C_KV_RANK], axis=-1)
    q = (rms_norm(c_q, q_norm_g) @ w_uq).reshape(b, s, C_HEADS, C_QK_DIM)
    q_n, q_r = q[..., :C_NOPE_DIM], q[..., C_NOPE_DIM:]
    q_r = apply_rope(q_r, cos[:, None, :], sin[:, None, :])
    k_r = apply_rope(k_r, cos, sin)
    kv = (rms_norm(c_kv, kv_norm_g) @ w_ukv).reshape(b, s, C_HEADS, C_NOPE_DIM + C_V_DIM)
    k_n, v = kv[..., :C_NOPE_DIM], kv[..., C_NOPE_DIM:]
    scale = C_QK_DIM ** -0.5

    def block(i):
        qnb = lax.dynamic_slice_in_dim(q_n, i * Q_BLOCK, Q_BLOCK, axis=1)
        qrb = lax.dynamic_slice_in_dim(q_r, i * Q_BLOCK, Q_BLOCK, axis=1)
        logits = (jnp.einsum('bqhd,bkhd->bhqk', qnb, k_n)
                  + jnp.einsum('bqhr,bkr->bhqk', qrb, k_r)).astype(jnp.float32) * scale
        p = jax.nn.softmax(logits, axis=-1).astype(v.dtype)
        return jnp.einsum('bhqk,bkhd->bqhd', p, v)

    o = unblock(lax.map(block, jnp.arange(s // Q_BLOCK)))
    return o.reshape(b, s, C_OUT_IN)


def setup_inputs(seed: int = 0) -> dict:
    key = jax.random.key(seed)
    ks = jax.random.split(key, 20)
    f32 = jnp.float32

    def w(k, shape, fan_in):
        return jax.random.normal(k, shape, f32) * (fan_in ** -0.5)

    def g(k, shape):
        return 1.0 + 0.02 * jax.random.normal(k, shape, f32)

    return {
        "x": jax.random.normal(ks[0], (BATCH, SEQ, D_MODEL), f32),
        "norm_mix_g": g(ks[1], (DEPTH, D_MODEL)),
        "norm_mlp_g": g(ks[2], (DEPTH, D_MODEL)),
        "ab_w_in": w(ks[3], (N_EVEN, D_MODEL, AB_IN_W), D_MODEL),
        "a_q_norm_g": g(ks[4], (N_EVEN, HEAD_DIM)),
        "a_k_norm_g": g(ks[5], (N_EVEN, HEAD_DIM)),
        "ab_w_out": w(ks[6], (N_EVEN, AB_OUT_IN, D_MODEL), AB_OUT_IN),
        "rel_bias": 0.2 * jax.random.normal(ks[7], (NUM_BUCKETS, B_HEADS), f32),
        "c_w_down": w(ks[8], (N_ODD, D_MODEL, C_DOWN_W), D_MODEL),
        "c_q_norm_g": g(ks[9], (N_ODD, C_Q_RANK)),
        "c_kv_norm_g": g(ks[10], (N_ODD, C_KV_RANK)),
        "c_w_uq": w(ks[11], (N_ODD, C_Q_RANK, C_HEADS * C_QK_DIM), C_Q_RANK),
        "c_w_ukv": w(ks[12], (N_ODD, C_KV_RANK, C_HEADS * (C_NOPE_DIM + C_V_DIM)), C_KV_RANK),
        "c_w_out": w(ks[13], (N_ODD, C_OUT_IN, D_MODEL), C_OUT_IN),
        "mlp_w1": w(ks[14], (DEPTH, D_MODEL, D_FF), D_MODEL),
        "mlp_w2": w(ks[15], (DEPTH, D_FF, D_MODEL), D_FF),
        "final_norm_g": g(ks[16], (D_MODEL,)),
    }


def reference(x, norm_mix_g, norm_mlp_g, ab_w_in, a_q_norm_g, a_k_norm_g, ab_w_out,
              rel_bias, c_w_down, c_q_norm_g, c_kv_norm_g, c_w_uq, c_w_ukv, c_w_out,
              mlp_w1, mlp_w2, final_norm_g):
    b, s, _ = x.shape
    rows = s // GRID_W
    row = jnp.repeat(jnp.arange(rows, dtype=jnp.int32), GRID_W)
    col = jnp.tile(jnp.arange(GRID_W, dtype=jnp.int32), rows)
    ang_ax = jnp.concatenate([rope_angles(row, HEAD_DIM // 2),
                              rope_angles(col, HEAD_DIM // 2)], axis=-1)
    cos_ax, sin_ax = jnp.cos(ang_ax)[:, None, :], jnp.sin(ang_ax)[:, None, :]
    ang_c = rope_angles(jnp.arange(s, dtype=jnp.int32), C_ROPE_DIM)
    cos_c, sin_c = jnp.cos(ang_c), jnp.sin(ang_c)
    split_ab = np.cumsum([A_Q_W, A_KV_W, A_KV_W, B_W, B_W]).tolist()

    h = x
    for layer in range(DEPTH):
        j = layer // 2
        hn = rms_norm(h, norm_mix_g[layer])
        if layer % 2 == 0:
            proj = hn @ ab_w_in[j]
            qa, ka, va, qb, kb, vb = jnp.split(proj, split_ab, axis=-1)
            qa = rms_norm(qa.reshape(b, s, A_HEADS, HEAD_DIM), a_q_norm_g[j])
            ka = rms_norm(ka.reshape(b, s, A_KV_HEADS, HEAD_DIM), a_k_norm_g[j])
            qa = apply_rope(qa, cos_ax, sin_ax)
            ka = apply_rope(ka, cos_ax, sin_ax)
            va = va.reshape(b, s, A_KV_HEADS, HEAD_DIM)
            o_a = gqa_attention(qa, ka, va)
            o_b = dilated_attention(qb.reshape(b, s, B_HEADS, HEAD_DIM),
                                    kb.reshape(b, s, B_HEADS, HEAD_DIM),
                                    vb.reshape(b, s, B_HEADS, HEAD_DIM), rel_bias)
            mix = jnp.concatenate([o_a, o_b], axis=-1) @ ab_w_out[j]
        else:
            o_c = mla_attention(hn, c_w_down[j], c_q_norm_g[j], c_kv_norm_g[j],
                                c_w_uq[j], c_w_ukv[j], cos_c, sin_c)
            mix = o_c @ c_w_out[j]
        h = h + mix
        hn = rms_norm(h, norm_mlp_g[layer])
        h = h + jnp.square(jax.nn.relu(hn @ mlp_w1[layer])) @ mlp_w2[layer]
    return rms_norm(h, final_norm_g)
```

```cpp
#include <hip/hip_runtime.h>
#include <cstdio>
#include <cstdint>

constexpr int BATCH = 8, SEQ = 2048, DM = 1024, M = BATCH * SEQ, FF = 4096;
constexpr int NPROJ = 2304;
constexpr int CDOWN = 416;
constexpr float EPS = 1e-6f;
typedef unsigned short bf16;

__device__ __forceinline__ float bf2f(bf16 v) { return __uint_as_float(((unsigned)v) << 16); }
__device__ __forceinline__ bf16 f2bf(float f) { unsigned u = __float_as_uint(f); return (bf16)((u + 0x7fffu + ((u >> 16) & 1u)) >> 16); }

__constant__ unsigned char BUCKET[3][129] = {
 {11,11,11,11,11,11,11,11,11,11,11,11,11,11,11,10,10,10,10,10,10,10,10,10,10,10,10,10,10,10,10,10,10,10,10,10,10,10,9,9,9,9,9,9,9,9,9,9,9,9,8,8,8,8,8,8,8,7,6,5,4,3,2,1,0,17,18,19,20,21,22,23,24,24,24,24,24,24,24,25,25,25,25,25,25,25,25,25,25,25,25,26,26,26,26,26,26,26,26,26,26,26,26,26,26,26,26,26,26,26,26,26,26,26,27,27,27,27,27,27,27,27,27,27,27,27,27,27,27},
 {13,13,13,13,13,13,13,13,13,13,13,13,13,13,13,13,13,13,13,13,13,13,13,12,12,12,12,12,12,12,12,12,12,12,12,12,12,12,12,12,12,12,11,11,11,11,11,11,11,11,11,11,10,10,10,10,10,10,9,9,9,8,8,4,0,20,24,24,25,25,25,26,26,26,26,26,26,27,27,27,27,27,27,27,27,27,27,28,28,28,28,28,28,28,28,28,28,28,28,28,28,28,28,28,28,28,29,29,29,29,29,29,29,29,29,29,29,29,29,29,29,29,29,29,29,29,29,29,29},
 {15,15,15,15,15,15,15,15,15,15,15,15,15,15,15,15,15,15,15,15,15,15,15,15,15,15,15,15,15,15,14,14,14,14,14,14,14,14,14,14,14,14,14,14,14,13,13,13,13,13,13,13,13,13,12,12,12,12,12,11,11,10,10,9,0,25,26,26,27,27,28,28,28,28,28,29,29,29,29,29,29,29,29,29,30,30,30,30,30,30,30,30,30,30,30,30,30,30,30,31,31,31,31,31,31,31,31,31,31,31,31,31,31,31,31,31,31,31,31,31,31,31,31,31,31,31,31,31,31}};

constexpr size_t MiB = 1u << 20;
constexpr size_t WS_TAB = 44 * MiB;
constexpr size_t WS_SS = 45 * MiB;
constexpr size_t WS_XN = 48 * MiB;
constexpr size_t WS_BIG = 80 * MiB;
constexpr size_t WS_PROJ = WS_BIG, WS_OAB = WS_BIG + 72 * MiB;
constexpr size_t WS_ACT = WS_BIG;
constexpr size_t WS_QN = WS_BIG, WS_QR = WS_BIG + 32 * MiB, WS_KN = WS_BIG + 48 * MiB, WS_VC = WS_BIG + 80 * MiB, WS_OC = WS_BIG + 112 * MiB;
constexpr size_t WS_CQ = 224 * MiB, WS_CKV = 232 * MiB, WS_KR = 236 * MiB;
constexpr size_t WS_END = 240 * MiB;

struct Tabs { const float *cosA, *sinA, *cosC, *sinC; };

__global__ void n_tables(float* tab) {
    int i = blockIdx.x * blockDim.x + threadIdx.x;
    float* cosA = tab; float* sinA = tab + 2048 * 32; float* cosC = tab + 2 * 2048 * 32; float* sinC = cosC + 2048 * 16;
    if (i < 2048 * 32) { int t = i / 32, j = i % 32; int p = (j < 16) ? (t / 64) : (t % 64); int jj = j & 15;
        double inv = pow(10000.0, -(double)(2 * jj) / 32.0); double a = (double)p * inv; cosA[i] = (float)cos(a); sinA[i] = (float)sin(a); }
    if (i < 2048 * 16) { int t = i / 16, j = i % 16; double inv = pow(10000.0, -(double)(2 * j) / 32.0); double a = (double)t * inv; cosC[i] = (float)cos(a); sinC[i] = (float)sin(a); }
}
__global__ void n_x_to_bf16(const float* x, bf16* XN, float* SS) {
    int row = blockIdx.x * 4 + (threadIdx.x >> 6), lane = threadIdx.x & 63;
    float s = 0.f;
    for (int c = lane; c < DM; c += 64) { float v = x[(size_t)row * DM + c]; s += v * v; XN[(size_t)row * DM + c] = f2bf(v); }
    for (int o = 1; o < 64; o <<= 1) s += __shfl_xor(s, o);
    if (lane < 16) SS[(size_t)row * 16 + lane] = lane == 0 ? s : 0.f;
}
template <class Epi>
__global__ void __launch_bounds__(256) n_gemm(const bf16* A, int lda, const float* W, int ldw, const float* gk, int K, Epi epi) {
    __shared__ float As[16][65]; __shared__ float Ws[16][65]; __shared__ float Cs[64][65];
    const int strip = blockIdx.x, row0 = blockIdx.y * 64, tid = threadIdx.x, tx = tid & 15, ty = tid >> 4;
    float acc[4][4] = {};
    for (int k0 = 0; k0 < K; k0 += 16) {
        for (int i = tid; i < 64 * 16; i += 256) { int r = i >> 4, kk = i & 15; As[kk][r] = bf2f(A[(size_t)(row0 + r) * lda + k0 + kk]); }
        for (int i = tid; i < 16 * 64; i += 256) { int kk = i >> 6, c = i & 63; int wc = epi.wcol(strip * 64 + c);
            Ws[kk][c] = wc < 0 ? 0.f : W[(size_t)(k0 + kk) * ldw + wc] * (gk ? gk[k0 + kk] : 1.f); }
        __syncthreads();
#pragma unroll
        for (int kk = 0; kk < 16; ++kk) { float a[4], b[4];
#pragma unroll
            for (int i = 0; i < 4; ++i) { a[i] = As[kk][ty * 4 + i]; b[i] = Ws[kk][tx * 4 + i]; }
#pragma unroll
            for (int i = 0; i < 4; ++i)
#pragma unroll
                for (int j = 0; j < 4; ++j) acc[i][j] += a[i] * b[j]; }
        __syncthreads();
    }
    for (int i = 0; i < 4; ++i) for (int j = 0; j < 4; ++j) Cs[ty * 4 + i][tx * 4 + j] = acc[i][j];
    __syncthreads();
    if (tid < 64) epi(row0 + tid, strip, &Cs[tid][0]);
}
__device__ __forceinline__ float rs_from(const float* p, int n, float dim) { float s = 0.f; for (int i = 0; i < n; ++i) s += p[i]; return rsqrtf(s / dim + EPS); }

struct NEpiInProj { const float* SS; bf16* PROJ; const float *gq, *gkk; Tabs T;
    __device__ int wcol(int n) const { return n; }
    __device__ void operator()(int row, int strip, float* c) const {
        const float rs = rs_from(SS + (size_t)row * 16, 16, 1024.f); const int t = row % SEQ;
        for (int d = 0; d < 64; ++d) c[d] *= rs;
        if (strip < 10) { const float* g = strip < 8 ? gq : gkk; float s = 0.f; for (int d = 0; d < 64; ++d) s += c[d] * c[d]; const float r = rsqrtf(s / 64.f + EPS);
            for (int d = 0; d < 64; ++d) c[d] = c[d] * r * g[d];
            for (int d = 0; d < 32; ++d) { const float co = T.cosA[t * 32 + d], si = T.sinA[t * 32 + d], x1 = c[d], x2 = c[d + 32]; c[d] = x1 * co - x2 * si; c[d + 32] = x2 * co + x1 * si; } }
        for (int d = 0; d < 64; ++d) PROJ[(size_t)row * NPROJ + strip * 64 + d] = f2bf(c[d]);
    } };
struct NEpiResid { const float* Hin; float* H; bf16* XN; float* SS;
    __device__ int wcol(int n) const { return n; }
    __device__ void operator()(int row, int strip, float* c) const { float s = 0.f;
        for (int d = 0; d < 64; ++d) { const size_t o = (size_t)row * DM + strip * 64 + d; const float h = Hin[o] + c[d]; H[o] = h; XN[o] = f2bf(h); s += h * h; }
        SS[(size_t)row * 16 + strip] = s; } };
struct NEpiAct { const float* SS; bf16* ACT;
    __device__ int wcol(int n) const { return n; }
    __device__ void operator()(int row, int strip, float* c) const { const float rs = rs_from(SS + (size_t)row * 16, 16, 1024.f);
        for (int d = 0; d < 64; ++d) { float v = fmaxf(c[d] * rs, 0.f); ACT[(size_t)row * FF + strip * 64 + d] = f2bf(v * v); } } };
struct NEpiDown { const float* SS; bf16 *CQ, *CKV, *KR; float *SSQ, *SSKV; Tabs T;
    __device__ int wcol(int n) const { return n < CDOWN ? n : -1; }
    __device__ void operator()(int row, int strip, float* c) const { const float rs = rs_from(SS + (size_t)row * 16, 16, 1024.f); const int t = row % SEQ;
        for (int d = 0; d < 64; ++d) c[d] *= rs;
        if (strip < 4) { float s = 0.f; for (int d = 0; d < 64; ++d) { s += c[d] * c[d]; CQ[(size_t)row * 256 + strip * 64 + d] = f2bf(c[d]); } SSQ[(size_t)row * 4 + strip] = s; }
        else if (strip < 6) { float s = 0.f; for (int d = 0; d < 64; ++d) { s += c[d] * c[d]; CKV[(size_t)row * 128 + (strip - 4) * 64 + d] = f2bf(c[d]); } SSKV[(size_t)row * 4 + strip - 4] = s; SSKV[(size_t)row * 4 + strip - 2] = 0.f; }
        else { for (int d = 0; d < 16; ++d) { const float co = T.cosC[t * 16 + d], si = T.sinC[t * 16 + d], x1 = c[d], x2 = c[d + 16];
                KR[(size_t)row * 32 + d] = f2bf(x1 * co - x2 * si); KR[(size_t)row * 32 + 16 + d] = f2bf(x2 * co + x1 * si); } } } };
struct NEpiUpQ { const float* SSQ; bf16 *QN, *QR; Tabs T;
    __device__ int wcol(int n) const { if (n < 1024) return (n >> 6) * 96 + (n & 63); n -= 1024; return (n >> 5) * 96 + 64 + (n & 31); }
    __device__ void operator()(int row, int strip, float* c) const { const float rs = rs_from(SSQ + (size_t)row * 4, 4, 256.f); const int t = row % SEQ;
        for (int d = 0; d < 64; ++d) c[d] *= rs;
        if (strip < 16) { for (int d = 0; d < 64; ++d) QN[(size_t)row * 1024 + strip * 64 + d] = f2bf(c[d]); }
        else { for (int hh = 0; hh < 2; ++hh) for (int d = 0; d < 16; ++d) { const float co = T.cosC[t * 16 + d], si = T.sinC[t * 16 + d], x1 = c[hh * 32 + d], x2 = c[hh * 32 + 16 + d];
                const size_t o = (size_t)row * 512 + (strip - 16) * 64 + hh * 32; QR[o + d] = f2bf(x1 * co - x2 * si); QR[o + 16 + d] = f2bf(x2 * co + x1 * si); } } } };
struct NEpiUpKV { const float* SSKV; bf16 *KN, *VC;
    __device__ int wcol(int n) const { if (n < 1024) return (n >> 6) * 128 + (n & 63); n -= 1024; return (n >> 6) * 128 + 64 + (n & 63); }
    __device__ void operator()(int row, int strip, float* c) const { const float rs = rs_from(SSKV + (size_t)row * 4, 4, 128.f);
        bf16* dst = strip < 16 ? KN + (size_t)row * 1024 + strip * 64 : VC + (size_t)row * 1024 + (strip - 16) * 64;
        for (int d = 0; d < 64; ++d) dst[d] = f2bf(c[d] * rs); } };

__global__ void __launch_bounds__(256) n_attn_gqa(const bf16* PROJ, bf16* OAB) {
    const int q = blockIdx.x * 256 + threadIdx.x, h = blockIdx.y, b = blockIdx.z, g = h >> 2;
    const size_t row = (size_t)b * SEQ + q;
    float qv[64], o[64]; for (int d = 0; d < 64; ++d) { qv[d] = bf2f(PROJ[row * NPROJ + h * 64 + d]) * 0.125f; o[d] = 0.f; }
    float m = -1e30f, l = 0.f;
    for (int k = 0; k < SEQ; ++k) { const bf16* kr = PROJ + ((size_t)b * SEQ + k) * NPROJ + 512 + g * 64; const bf16* vr = kr + 128;
        float s = 0.f; for (int d = 0; d < 64; ++d) s += qv[d] * bf2f(kr[d]);
        const float mn = fmaxf(m, s), a = __expf(m - mn), p = __expf(s - mn); l = l * a + p; for (int d = 0; d < 64; ++d) o[d] = o[d] * a + p * bf2f(vr[d]); m = mn; }
    const float il = 1.f / l; for (int d = 0; d < 64; ++d) OAB[row * DM + h * 64 + d] = f2bf(o[d] * il);
}
__global__ void __launch_bounds__(256) n_attn_dil(const bf16* PROJ, const float* relb, bf16* OAB) {
    const int q = blockIdx.x * 256 + threadIdx.x, h = blockIdx.y, b = blockIdx.z; const size_t row = (size_t)b * SEQ + q;
    float qv[64], o[64]; for (int d = 0; d < 64; ++d) { qv[d] = bf2f(PROJ[row * NPROJ + 768 + h * 64 + d]) * 0.125f; o[d] = 0.f; }
    float m = -1e30f, l = 0.f;
    for (int br = 0; br < 3; ++br) { const int dil = br == 0 ? 1 : (br == 1 ? 4 : 16);
        for (int j = -64; j <= 64; ++j) { const int pos = q + j * dil; if (pos < 0 || pos >= SEQ) continue;
            const bf16* kr = PROJ + ((size_t)b * SEQ + pos) * NPROJ + 1280 + h * 64; const bf16* vr = kr + 512;
            float s = 0.f; for (int d = 0; d < 64; ++d) s += qv[d] * bf2f(kr[d]); s += relb[BUCKET[br][j + 64] * 8 + h];
            const float mn = fmaxf(m, s), a = __expf(m - mn), p = __expf(s - mn); l = l * a + p; for (int d = 0; d < 64; ++d) o[d] = o[d] * a + p * bf2f(vr[d]); m = mn; } }
    const float il = 1.f / l; for (int d = 0; d < 64; ++d) OAB[row * DM + 512 + h * 64 + d] = f2bf(o[d] * il);
}
__global__ void __launch_bounds__(256) n_attn_mla(const bf16* QN, const bf16* QR, const bf16* KN, const bf16* KR, const bf16* VC, bf16* OC) {
    const int q = blockIdx.x * 256 + threadIdx.x, h = blockIdx.y, b = blockIdx.z; const size_t row = (size_t)b * SEQ + q;
    const float sc = 0.10206207261596575f;
    float qv[96], o[64]; for (int d = 0; d < 64; ++d) { qv[d] = bf2f(QN[row * 1024 + h * 64 + d]) * sc; o[d] = 0.f; }
    for (int d = 0; d < 32; ++d) qv[64 + d] = bf2f(QR[row * 512 + h * 32 + d]) * sc;
    float m = -1e30f, l = 0.f;
    for (int k = 0; k < SEQ; ++k) { const size_t kr = (size_t)b * SEQ + k; const bf16* kn = KN + kr * 1024 + h * 64; const bf16* kq = KR + kr * 32; const bf16* vr = VC + kr * 1024 + h * 64;
        float s = 0.f; for (int d = 0; d < 64; ++d) s += qv[d] * bf2f(kn[d]); for (int d = 0; d < 32; ++d) s += qv[64 + d] * bf2f(kq[d]);
        const float mn = fmaxf(m, s), a = __expf(m - mn), p = __expf(s - mn); l = l * a + p; for (int d = 0; d < 64; ++d) o[d] = o[d] * a + p * bf2f(vr[d]); m = mn; }
    const float il = 1.f / l; for (int d = 0; d < 64; ++d) OC[row * 1024 + h * 64 + d] = f2bf(o[d] * il);
}
__global__ void n_final(float* H, const float* g) {
    int row = blockIdx.x * 4 + (threadIdx.x >> 6), lane = threadIdx.x & 63; float v[16]; float s = 0.f;
    for (int i = 0; i < 16; ++i) { v[i] = H[(size_t)row * DM + lane + 64 * i]; s += v[i] * v[i]; }
    for (int o = 1; o < 64; o <<= 1) s += __shfl_xor(s, o);
    const float r = rsqrtf(s / 1024.f + EPS);
    for (int i = 0; i < 16; ++i) H[(size_t)row * DM + lane + 64 * i] = v[i] * r * g[lane + 64 * i];
}

extern "C" void kernel_launch(void* const* d_in, const int* in_sizes, int n_in, void* d_out, int out_size, void* d_ws, size_t ws_size, hipStream_t stream) {
    if (n_in != 17 || out_size != M * DM || ws_size < WS_END) { fprintf(stderr, "kernel_launch: unexpected shapes n_in %d out %d ws %zu\n", n_in, out_size, ws_size); return; }
    const float* x = (const float*)d_in[0]; const float* g_mix = (const float*)d_in[1]; const float* g_mlp = (const float*)d_in[2]; const float* w_in = (const float*)d_in[3];
    const float* gq = (const float*)d_in[4]; const float* gk = (const float*)d_in[5]; const float* w_out = (const float*)d_in[6]; const float* relb = (const float*)d_in[7];
    const float* w_down = (const float*)d_in[8]; const float* gqn = (const float*)d_in[9]; const float* gkvn = (const float*)d_in[10]; const float* w_uq = (const float*)d_in[11];
    const float* w_ukv = (const float*)d_in[12]; const float* w_cout = (const float*)d_in[13]; const float* w1 = (const float*)d_in[14]; const float* w2 = (const float*)d_in[15];
    const float* g_fin = (const float*)d_in[16];
    unsigned char* ws = (unsigned char*)d_ws; float* H = (float*)d_out;
    float* tab = (float*)(ws + WS_TAB); Tabs T{tab, tab + 2048 * 32, tab + 2 * 2048 * 32, tab + 2 * 2048 * 32 + 2048 * 16};
    float* SS = (float*)(ws + WS_SS); float* SSQ = SS + (size_t)M * 16; float* SSKV = SSQ + (size_t)M * 4;
    bf16* XN = (bf16*)(ws + WS_XN); bf16* PROJ = (bf16*)(ws + WS_PROJ); bf16* OAB = (bf16*)(ws + WS_OAB); bf16* ACT = (bf16*)(ws + WS_ACT);
    bf16* QN = (bf16*)(ws + WS_QN); bf16* QR = (bf16*)(ws + WS_QR); bf16* KN = (bf16*)(ws + WS_KN); bf16* VC = (bf16*)(ws + WS_VC); bf16* OC = (bf16*)(ws + WS_OC);
    bf16* CQ = (bf16*)(ws + WS_CQ); bf16* CKV = (bf16*)(ws + WS_CKV); bf16* KR = (bf16*)(ws + WS_KR);

    n_tables<<<(2048 * 32 + 255) / 256, 256, 0, stream>>>(tab);
    n_x_to_bf16<<<M / 4, 256, 0, stream>>>(x, XN, SS);
    n_gemm<NEpiInProj><<<dim3(NPROJ / 64, M / 64), 256, 0, stream>>>(XN, DM, w_in, NPROJ, g_mix, DM, NEpiInProj{SS, PROJ, gq, gk, T});
    n_attn_gqa<<<dim3(SEQ / 256, 8, BATCH), 256, 0, stream>>>(PROJ, OAB);
    n_attn_dil<<<dim3(SEQ / 256, 8, BATCH), 256, 0, stream>>>(PROJ, relb, OAB);
    n_gemm<NEpiResid><<<dim3(DM / 64, M / 64), 256, 0, stream>>>(OAB, DM, w_out, DM, nullptr, DM, NEpiResid{x, H, XN, SS});
    n_gemm<NEpiAct><<<dim3(FF / 64, M / 64), 256, 0, stream>>>(XN, DM, w1, FF, g_mlp, DM, NEpiAct{SS, ACT});
    n_gemm<NEpiResid><<<dim3(DM / 64, M / 64), 256, 0, stream>>>(ACT, FF, w2, DM, nullptr, FF, NEpiResid{H, H, XN, SS});
    n_gemm<NEpiDown><<<dim3(7, M / 64), 256, 0, stream>>>(XN, DM, w_down, CDOWN, g_mix + DM, DM, NEpiDown{SS, CQ, CKV, KR, SSQ, SSKV, T});
    n_gemm<NEpiUpQ><<<dim3(24, M / 64), 256, 0, stream>>>(CQ, 256, w_uq, 1536, gqn, 256, NEpiUpQ{SSQ, QN, QR, T});
    n_gemm<NEpiUpKV><<<dim3(32, M / 64), 256, 0, stream>>>(CKV, 128, w_ukv, 2048, gkvn, 128, NEpiUpKV{SSKV, KN, VC});
    n_attn_mla<<<dim3(SEQ / 256, 16, BATCH), 256, 0, stream>>>(QN, QR, KN, KR, VC, OC);
    n_gemm<NEpiResid><<<dim3(DM / 64, M / 64), 256, 0, stream>>>(OC, DM, w_cout, DM, nullptr, DM, NEpiResid{H, H, XN, SS});
    n_gemm<NEpiAct><<<dim3(FF / 64, M / 64), 256, 0, stream>>>(XN, DM, w1 + (size_t)DM * FF, FF, g_mlp + DM, DM, NEpiAct{SS, ACT});
    n_gemm<NEpiResid><<<dim3(DM / 64, M / 64), 256, 0, stream>>>(ACT, FF, w2 + (size_t)FF * DM, DM, nullptr, FF, NEpiResid{H, H, XN, SS});
    n_final<<<M / 4, 256, 0, stream>>>(H, g_fin);
}
```

```cpp
#include <hip/hip_runtime.h>
#include <cstdio>
#include <cstdint>

constexpr int BATCH = 8, SEQ = 2048, DM = 1024, M = BATCH * SEQ, FF = 4096;
constexpr int NPROJ = 2304;
constexpr int CDOWN = 416;
constexpr float EPS = 1e-6f;
typedef unsigned short bf16;

__device__ __forceinline__ float bf2f(bf16 v) { return __uint_as_float(((unsigned)v) << 16); }
__device__ __forceinline__ bf16 f2bf(float f) { unsigned u = __float_as_uint(f); return (bf16)((u + 0x7fffu + ((u >> 16) & 1u)) >> 16); }

__constant__ unsigned char BUCKET[3][129] = {
 {11,11,11,11,11,11,11,11,11,11,11,11,11,11,11,10,10,10,10,10,10,10,10,10,10,10,10,10,10,10,10,10,10,10,10,10,10,10,9,9,9,9,9,9,9,9,9,9,9,9,8,8,8,8,8,8,8,7,6,5,4,3,2,1,0,17,18,19,20,21,22,23,24,24,24,24,24,24,24,25,25,25,25,25,25,25,25,25,25,25,25,26,26,26,26,26,26,26,26,26,26,26,26,26,26,26,26,26,26,26,26,26,26,26,27,27,27,27,27,27,27,27,27,27,27,27,27,27,27},
 {13,13,13,13,13,13,13,13,13,13,13,13,13,13,13,13,13,13,13,13,13,13,13,12,12,12,12,12,12,12,12,12,12,12,12,12,12,12,12,12,12,12,11,11,11,11,11,11,11,11,11,11,10,10,10,10,10,10,9,9,9,8,8,4,0,20,24,24,25,25,25,26,26,26,26,26,26,27,27,27,27,27,27,27,27,27,27,28,28,28,28,28,28,28,28,28,28,28,28,28,28,28,28,28,28,28,29,29,29,29,29,29,29,29,29,29,29,29,29,29,29,29,29,29,29,29,29,29,29},
 {15,15,15,15,15,15,15,15,15,15,15,15,15,15,15,15,15,15,15,15,15,15,15,15,15,15,15,15,15,15,14,14,14,14,14,14,14,14,14,14,14,14,14,14,14,13,13,13,13,13,13,13,13,13,12,12,12,12,12,11,11,10,10,9,0,25,26,26,27,27,28,28,28,28,28,29,29,29,29,29,29,29,29,29,30,30,30,30,30,30,30,30,30,30,30,30,30,30,30,31,31,31,31,31,31,31,31,31,31,31,31,31,31,31,31,31,31,31,31,31,31,31,31,31,31,31,31,31,31}};

constexpr size_t MiB = 1u << 20;
constexpr size_t WS_TAB = 45 * MiB;
constexpr size_t WS_SS = 46 * MiB;
constexpr size_t WS_XN = 48 * MiB;
constexpr size_t WS_BIG = 80 * MiB;
constexpr size_t WS_PROJ = WS_BIG, WS_OAB = WS_BIG + 72 * MiB;
constexpr size_t WS_ACT = WS_BIG;
constexpr size_t WS_QN = WS_BIG, WS_QR = WS_BIG + 32 * MiB, WS_KN = WS_BIG + 48 * MiB, WS_VC = WS_BIG + 80 * MiB, WS_OC = WS_BIG + 112 * MiB;
constexpr size_t WS_CQ = 224 * MiB, WS_CKV = 232 * MiB, WS_KR = 236 * MiB;
constexpr size_t WS_END = 240 * MiB;

struct Tabs { const float *cosA, *sinA, *cosC, *sinC; };

__global__ void n_tables(float* tab) {
    int i = blockIdx.x * blockDim.x + threadIdx.x;
    float* cosA = tab; float* sinA = tab + 2048 * 32; float* cosC = tab + 2 * 2048 * 32; float* sinC = cosC + 2048 * 16;
    if (i < 2048 * 32) { int t = i / 32, j = i % 32; int p = (j < 16) ? (t / 64) : (t % 64); int jj = j & 15;
        double inv = pow(10000.0, -(double)(2 * jj) / 32.0); double a = (double)p * inv; cosA[i] = (float)cos(a); sinA[i] = (float)sin(a); }
    if (i < 2048 * 16) { int t = i / 16, j = i % 16; double inv = pow(10000.0, -(double)(2 * j) / 32.0); double a = (double)t * inv; cosC[i] = (float)cos(a); sinC[i] = (float)sin(a); }
}
__global__ void n_x_to_bf16(const float* x, bf16* XN, float* SS) {
    int row = blockIdx.x * 4 + (threadIdx.x >> 6), lane = threadIdx.x & 63;
    float s = 0.f;
    for (int c = lane; c < DM; c += 64) { float v = x[(size_t)row * DM + c]; s += v * v; XN[(size_t)row * DM + c] = f2bf(v); }
    for (int o = 1; o < 64; o <<= 1) s += __shfl_xor(s, o);
    if (lane < 16) SS[(size_t)row * 16 + lane] = lane == 0 ? s : 0.f;
}
template <class Epi>
__global__ void __launch_bounds__(256) n_gemm(const bf16* A, int lda, const float* W, int ldw, const float* gk, int K, Epi epi) {
    __shared__ float As[16][65]; __shared__ float Ws[16][65]; __shared__ float Cs[64][65];
    const int strip = blockIdx.x, row0 = blockIdx.y * 64, tid = threadIdx.x, tx = tid & 15, ty = tid >> 4;
    float acc[4][4] = {};
    for (int k0 = 0; k0 < K; k0 += 16) {
        for (int i = tid; i < 64 * 16; i += 256) { int r = i >> 4, kk = i & 15; As[kk][r] = bf2f(A[(size_t)(row0 + r) * lda + k0 + kk]); }
        for (int i = tid; i < 16 * 64; i += 256) { int kk = i >> 6, c = i & 63; int wc = epi.wcol(strip * 64 + c);
            Ws[kk][c] = wc < 0 ? 0.f : W[(size_t)(k0 + kk) * ldw + wc] * (gk ? gk[k0 + kk] : 1.f); }
        __syncthreads();
#pragma unroll
        for (int kk = 0; kk < 16; ++kk) { float a[4], b[4];
#pragma unroll
            for (int i = 0; i < 4; ++i) { a[i] = As[kk][ty * 4 + i]; b[i] = Ws[kk][tx * 4 + i]; }
#pragma unroll
            for (int i = 0; i < 4; ++i)
#pragma unroll
                for (int j = 0; j < 4; ++j) acc[i][j] += a[i] * b[j]; }
        __syncthreads();
    }
    for (int i = 0; i < 4; ++i) for (int j = 0; j < 4; ++j) Cs[ty * 4 + i][tx * 4 + j] = acc[i][j];
    __syncthreads();
    if (tid < 64) epi(row0 + tid, strip, &Cs[tid][0]);
}
__device__ __forceinline__ float rs_from(const float* p, int n, float dim) { float s = 0.f; for (int i = 0; i < n; ++i) s += p[i]; return rsqrtf(s / dim + EPS); }

struct NEpiInProj { const float* SS; bf16* PROJ; const float *gq, *gkk; Tabs T;
    __device__ int wcol(int n) const { return n; }
    __device__ void operator()(int row, int strip, float* c) const {
        const float rs = rs_from(SS + (size_t)row * 16, 16, 1024.f); const int t = row % SEQ;
        for (int d = 0; d < 64; ++d) c[d] *= rs;
        if (strip < 10) { const float* g = strip < 8 ? gq : gkk; float s = 0.f; for (int d = 0; d < 64; ++d) s += c[d] * c[d]; const float r = rsqrtf(s / 64.f + EPS);
            for (int d = 0; d < 64; ++d) c[d] = c[d] * r * g[d];
            for (int d = 0; d < 32; ++d) { const float co = T.cosA[t * 32 + d], si = T.sinA[t * 32 + d], x1 = c[d], x2 = c[d + 32]; c[d] = x1 * co - x2 * si; c[d + 32] = x2 * co + x1 * si; } }
        for (int d = 0; d < 64; ++d) PROJ[(size_t)row * NPROJ + strip * 64 + d] = f2bf(c[d]);
    } };
struct NEpiResid { const float* Hin; float* H; bf16* XN; float* SS;
    __device__ int wcol(int n) const { return n; }
    __device__ void operator()(int row, int strip, float* c) const { float s = 0.f;
        for (int d = 0; d < 64; ++d) { const size_t o = (size_t)row * DM + strip * 64 + d; const float h = Hin[o] + c[d]; H[o] = h; XN[o] = f2bf(h); s += h * h; }
        SS[(size_t)row * 16 + strip] = s; } };
struct NEpiAct { const float* SS; bf16* ACT;
    __device__ int wcol(int n) const { return n; }
    __device__ void operator()(int row, int strip, float* c) const { const float rs = rs_from(SS + (size_t)row * 16, 16, 1024.f);
        for (int d = 0; d < 64; ++d) { float v = fmaxf(c[d] * rs, 0.f); ACT[(size_t)row * FF + strip * 64 + d] = f2bf(v * v); } } };
struct NEpiDown { const float* SS; bf16 *CQ, *CKV, *KR; float *SSQ, *SSKV; Tabs T;
    __device__ int wcol(int n) const { return n < CDOWN ? n : -1; }
    __device__ void operator()(int row, int strip, float* c) const { const float rs = rs_from(SS + (size_t)row * 16, 16, 1024.f); const int t = row % SEQ;
        for (int d = 0; d < 64; ++d) c[d] *= rs;
        if (strip < 4) { float s = 0.f; for (int d = 0; d < 64; ++d) { s += c[d] * c[d]; CQ[(size_t)row * 256 + strip * 64 + d] = f2bf(c[d]); } SSQ[(size_t)row * 4 + strip] = s; }
        else if (strip < 6) { float s = 0.f; for (int d = 0; d < 64; ++d) { s += c[d] * c[d]; CKV[(size_t)row * 128 + (strip - 4) * 64 + d] = f2bf(c[d]); } SSKV[(size_t)row * 4 + strip - 4] = s; SSKV[(size_t)row * 4 + strip - 2] = 0.f; }
        else { for (int d = 0; d < 16; ++d) { const float co = T.cosC[t * 16 + d], si = T.sinC[t * 16 + d], x1 = c[d], x2 = c[d + 16];
                KR[(size_t)row * 32 + d] = f2bf(x1 * co - x2 * si); KR[(size_t)row * 32 + 16 + d] = f2bf(x2 * co + x1 * si); } } } };
struct NEpiUpQ { const float* SSQ; bf16 *QN, *QR; Tabs T;
    __device__ int wcol(int n) const { if (n < 1024) return (n >> 6) * 96 + (n & 63); n -= 1024; return (n >> 5) * 96 + 64 + (n & 31); }
    __device__ void operator()(int row, int strip, float* c) const { const float rs = rs_from(SSQ + (size_t)row * 4, 4, 256.f); const int t = row % SEQ;
        for (int d = 0; d < 64; ++d) c[d] *= rs;
        if (strip < 16) { for (int d = 0; d < 64; ++d) QN[(size_t)row * 1024 + strip * 64 + d] = f2bf(c[d]); }
        else { for (int hh = 0; hh < 2; ++hh) for (int d = 0; d < 16; ++d) { const float co = T.cosC[t * 16 + d], si = T.sinC[t * 16 + d], x1 = c[hh * 32 + d], x2 = c[hh * 32 + 16 + d];
                const size_t o = (size_t)row * 512 + (strip - 16) * 64 + hh * 32; QR[o + d] = f2bf(x1 * co - x2 * si); QR[o + 16 + d] = f2bf(x2 * co + x1 * si); } } } };
struct NEpiUpKV { const float* SSKV; bf16 *KN, *VC;
    __device__ int wcol(int n) const { if (n < 1024) return (n >> 6) * 128 + (n & 63); n -= 1024; return (n >> 6) * 128 + 64 + (n & 63); }
    __device__ void operator()(int row, int strip, float* c) const { const float rs = rs_from(SSKV + (size_t)row * 4, 4, 128.f);
        bf16* dst = strip < 16 ? KN + (size_t)row * 1024 + strip * 64 : VC + (size_t)row * 1024 + (strip - 16) * 64;
        for (int d = 0; d < 64; ++d) dst[d] = f2bf(c[d] * rs); } };

__global__ void __launch_bounds__(256) n_attn_gqa(const bf16* PROJ, bf16* OAB) {
    const int q = blockIdx.x * 256 + threadIdx.x, h = blockIdx.y, b = blockIdx.z, g = h >> 2;
    const size_t row = (size_t)b * SEQ + q;
    float qv[64], o[64]; for (int d = 0; d < 64; ++d) { qv[d] = bf2f(PROJ[row * NPROJ + h * 64 + d]) * 0.125f; o[d] = 0.f; }
    float m = -1e30f, l = 0.f;
    for (int k = 0; k < SEQ; ++k) { const bf16* kr = PROJ + ((size_t)b * SEQ + k) * NPROJ + 512 + g * 64; const bf16* vr = kr + 128;
        float s = 0.f; for (int d = 0; d < 64; ++d) s += qv[d] * bf2f(kr[d]);
        const float mn = fmaxf(m, s), a = __expf(m - mn), p = __expf(s - mn); l = l * a + p; for (int d = 0; d < 64; ++d) o[d] = o[d] * a + p * bf2f(vr[d]); m = mn; }
    const float il = 1.f / l; for (int d = 0; d < 64; ++d) OAB[row * DM + h * 64 + d] = f2bf(o[d] * il);
}
__global__ void __launch_bounds__(256) n_attn_dil(const bf16* PROJ, const float* relb, bf16* OAB) {
    const int q = blockIdx.x * 256 + threadIdx.x, h = blockIdx.y, b = blockIdx.z; const size_t row = (size_t)b * SEQ + q;
    float qv[64], o[64]; for (int d = 0; d < 64; ++d) { qv[d] = bf2f(PROJ[row * NPROJ + 768 + h * 64 + d]) * 0.125f; o[d] = 0.f; }
    float m = -1e30f, l = 0.f;
    for (int br = 0; br < 3; ++br) { const int dil = br == 0 ? 1 : (br == 1 ? 4 : 16);
        for (int j = -64; j <= 64; ++j) { const int pos = q + j * dil; if (pos < 0 || pos >= SEQ) continue;
            const bf16* kr = PROJ + ((size_t)b * SEQ + pos) * NPROJ + 1280 + h * 64; const bf16* vr = kr + 512;
            float s = 0.f; for (int d = 0; d < 64; ++d) s += qv[d] * bf2f(kr[d]); s += relb[BUCKET[br][j + 64] * 8 + h];
            const float mn = fmaxf(m, s), a = __expf(m - mn), p = __expf(s - mn); l = l * a + p; for (int d = 0; d < 64; ++d) o[d] = o[d] * a + p * bf2f(vr[d]); m = mn; } }
    const float il = 1.f / l; for (int d = 0; d < 64; ++d) OAB[row * DM + 512 + h * 64 + d] = f2bf(o[d] * il);
}
__global__ void __launch_bounds__(256) n_attn_mla(const bf16* QN, const bf16* QR, const bf16* KN, const bf16* KR, const bf16* VC, bf16* OC) {
    const int q = blockIdx.x * 256 + threadIdx.x, h = blockIdx.y, b = blockIdx.z; const size_t row = (size_t)b * SEQ + q;
    const float sc = 0.10206207261596575f;
    float qv[96], o[64]; for (int d = 0; d < 64; ++d) { qv[d] = bf2f(QN[row * 1024 + h * 64 + d]) * sc; o[d] = 0.f; }
    for (int d = 0; d < 32; ++d) qv[64 + d] = bf2f(QR[row * 512 + h * 32 + d]) * sc;
    float m = -1e30f, l = 0.f;
    for (int k = 0; k < SEQ; ++k) { const size_t kr = (size_t)b * SEQ + k; const bf16* kn = KN + kr * 1024 + h * 64; const bf16* kq = KR + kr * 32; const bf16* vr = VC + kr * 1024 + h * 64;
        float s = 0.f; for (int d = 0; d < 64; ++d) s += qv[d] * bf2f(kn[d]); for (int d = 0; d < 32; ++d) s += qv[64 + d] * bf2f(kq[d]);
        const float mn = fmaxf(m, s), a = __expf(m - mn), p = __expf(s - mn); l = l * a + p; for (int d = 0; d < 64; ++d) o[d] = o[d] * a + p * bf2f(vr[d]); m = mn; }
    const float il = 1.f / l; for (int d = 0; d < 64; ++d) OC[row * 1024 + h * 64 + d] = f2bf(o[d] * il);
}
__global__ void n_final(float* H, const float* g) {
    int row = blockIdx.x * 4 + (threadIdx.x >> 6), lane = threadIdx.x & 63; float v[16]; float s = 0.f;
    for (int i = 0; i < 16; ++i) { v[i] = H[(size_t)row * DM + lane + 64 * i]; s += v[i] * v[i]; }
    for (int o = 1; o < 64; o <<= 1) s += __shfl_xor(s, o);
    const float r = rsqrtf(s / 1024.f + EPS);
    for (int i = 0; i < 16; ++i) H[(size_t)row * DM + lane + 64 * i] = v[i] * r * g[lane + 64 * i];
}


namespace pg8 {
#define PG8_LAS __attribute__((address_space(3)))
typedef unsigned short bf16_t;
typedef short bf16x8 __attribute__((ext_vector_type(8)));
typedef float f32x4 __attribute__((ext_vector_type(4)));
typedef unsigned u32x4 __attribute__((ext_vector_type(4)));
constexpr int BM = 256, BK = 64, HALF = 128, HTB = HALF * BK * 2  , STAGE_BYTES = 8 * HTB, NXCD = 8, WGM = 8;

__host__ __device__ __forceinline__ int lds_byte(int r, int c) { const int st = (r >> 4) * 2 + (c >> 5), rr = r & 15, cc = c & 31, ob = rr * 64 + cc * 2; return st * 1024 + (ob ^ (((ob >> 9) & 1) << 5)); }
__host__ __device__ __forceinline__ void stage_rc(int b, int& R, int& C) { const int st = b / 1024, sb = b % 1024, swz = sb ^ (((sb >> 9) & 1) << 5); R = (st >> 1) * 16 + swz / 64; C = (st & 1) * 32 + (swz % 64) / 2; }
__host__ __device__ __forceinline__ int perm32(int rho) { const int n = rho >> 4, i = rho & 15; return 8 * (i >> 2) + 4 * n + (i & 3); }

struct Unit { int pm, pn; };
struct Gemm { const bf16_t* A; const bf16_t* Bt; int M, N, K; };

struct StaticOrder {
    int nM, nN, nwg, G, c;
    __host__ __device__ void init(int M, int N, int G_, int c_) { nM = M / BM; nN = N / BM; nwg = nM * nN; G = G_; c = c_; }
    __host__ __device__ bool next(int i, Unit& u) const {
        const long L = (long)i * G + c; if (L >= nwg) return false;
        int wgid = (int)L; { const int q = nwg / NXCD, r = nwg % NXCD, xcd = wgid % NXCD, off = wgid / NXCD; wgid = (xcd < r ? xcd * (q + 1) : r * (q + 1) + (xcd - r) * q) + off; }
        const int nig = WGM * nN, gid = wgid / nig, fm = gid * WGM, gsz = (nM - fm) < WGM ? (nM - fm) : WGM;
        u.pm = fm + ((wgid % nig) % gsz); u.pn = (wgid % nig) / gsz; return true;
    }
    __device__ __forceinline__ void a_ready(const Unit&) const {}
    __device__ __forceinline__ void done(const Unit&) const {}
};


__device__ __forceinline__ unsigned cvt_pk_bf16(float lo, float hi) { unsigned r; asm volatile("v_cvt_pk_bf16_f32 %0, %1, %2" : "=v"(r) : "v"(lo), "v"(hi)); return r; }
__device__ __forceinline__ u32x4 pack8(const f32x4 a, const f32x4 b) { u32x4 w; w.x = cvt_pk_bf16(a[0], a[1]); w.y = cvt_pk_bf16(a[2], a[3]); w.z = cvt_pk_bf16(b[0], b[1]); w.w = cvt_pk_bf16(b[2], b[3]); return w; }
__device__ __forceinline__ float hsum4(const f32x4 a) { return (a[0] + a[1]) + (a[2] + a[3]); }
__device__ __forceinline__ float row_rs16(const float* SS, int row, float inv_dim) { const f32x4* p = (const f32x4*)(SS + (size_t)row * 16); const f32x4 a = p[0], b = p[1], c = p[2], d = p[3];
    return rsqrtf(((hsum4(a) + hsum4(b)) + (hsum4(c) + hsum4(d))) * inv_dim + 1e-6f); }
__device__ __forceinline__ float row_rs4(const float* SS4, int row, float inv_dim) { const f32x4 a = *(const f32x4*)(SS4 + (size_t)row * 4); return rsqrtf(hsum4(a) * inv_dim + 1e-6f); }
__device__ __forceinline__ float quad_sum(float s) { s += __shfl_xor(s, 16); s += __shfl_xor(s, 32); return s; }

struct EpiInProj { static constexpr bool PERM = true, AFTER_DRAIN = false;
    const float* SS; bf16_t* PROJ; const float* gq; const float* gk; const float* cosA; const float* sinA;
    __device__ __forceinline__ void operator()(const f32x4 (&acc)[2][2][4][2], const Unit& u, int wr, int wc, int fr, int fq) const {
        const int strip = u.pn * 4 + wc; const bool normed = strip < 10; const float* g = strip < 8 ? gq : gk;
        f32x4 gv[2][2];
#pragma unroll
        for (int bj = 0; bj < 2; ++bj)
#pragma unroll
            for (int n = 0; n < 2; ++n) gv[bj][n] = *(const f32x4*)(g + 32 * bj + 8 * fq + 4 * n);
#pragma unroll
        for (int ai = 0; ai < 2; ++ai)
#pragma unroll
            for (int m = 0; m < 4; ++m) {
                const int row = u.pm * BM + ai * HALF + wr * 64 + m * 16 + fr;
                const float rs = row_rs16(SS, row, 1.0f / 1024.0f);
                f32x4 v[2][2];
#pragma unroll
                for (int bj = 0; bj < 2; ++bj)
#pragma unroll
                    for (int n = 0; n < 2; ++n) v[bj][n] = acc[ai][bj][m][n] * rs;
                if (normed) {
                    float ss = 0.f;
#pragma unroll
                    for (int bj = 0; bj < 2; ++bj)
#pragma unroll
                        for (int n = 0; n < 2; ++n) ss += hsum4(v[bj][n] * v[bj][n]);
                    ss = quad_sum(ss);
                    const float r = rsqrtf(ss * (1.0f / 64.0f) + 1e-6f);
#pragma unroll
                    for (int bj = 0; bj < 2; ++bj)
#pragma unroll
                        for (int n = 0; n < 2; ++n) v[bj][n] = v[bj][n] * r * gv[bj][n];
                    const int t = row & 2047;
#pragma unroll
                    for (int n = 0; n < 2; ++n) { const f32x4 c = *(const f32x4*)(cosA + t * 32 + 8 * fq + 4 * n), s = *(const f32x4*)(sinA + t * 32 + 8 * fq + 4 * n);
                        const f32x4 x1 = v[0][n], x2 = v[1][n]; v[0][n] = x1 * c - x2 * s; v[1][n] = x2 * c + x1 * s; }
                }
                bf16_t* dst = PROJ + (size_t)row * 2304 + strip * 64 + 8 * fq;
#pragma unroll
                for (int bj = 0; bj < 2; ++bj) *(u32x4*)(dst + 32 * bj) = pack8(v[bj][0], v[bj][1]);
            }
    }
};
struct EpiResid { static constexpr bool PERM = true, AFTER_DRAIN = false;
    const float* Hin; float* H; bf16_t* XN; float* SS;
    __device__ __forceinline__ void operator()(const f32x4 (&acc)[2][2][4][2], const Unit& u, int wr, int wc, int fr, int fq) const {
#pragma unroll
        for (int ai = 0; ai < 2; ++ai)
#pragma unroll
            for (int m = 0; m < 4; ++m) {
                const int row = u.pm * BM + ai * HALF + wr * 64 + m * 16 + fr; float ss = 0.f;
#pragma unroll
                for (int bj = 0; bj < 2; ++bj) { const size_t o = (size_t)row * 1024 + u.pn * BM + bj * HALF + wc * 32 + 8 * fq;
                    const f32x4 h0 = *(const f32x4*)(Hin + o) + acc[ai][bj][m][0], h1 = *(const f32x4*)(Hin + o + 4) + acc[ai][bj][m][1];
                    *(f32x4*)(H + o) = h0; *(f32x4*)(H + o + 4) = h1; *(u32x4*)(XN + o) = pack8(h0, h1); ss += hsum4(h0 * h0) + hsum4(h1 * h1); }
                ss = quad_sum(ss);
                if (fq == 0) SS[(size_t)row * 16 + u.pn * 4 + wc] = ss;
            }
    }
};
struct EpiAct { static constexpr bool PERM = true, AFTER_DRAIN = false;
    const float* SS; bf16_t* ACT;
    __device__ __forceinline__ void operator()(const f32x4 (&acc)[2][2][4][2], const Unit& u, int wr, int wc, int fr, int fq) const {
#pragma unroll
        for (int ai = 0; ai < 2; ++ai)
#pragma unroll
            for (int m = 0; m < 4; ++m) {
                const int row = u.pm * BM + ai * HALF + wr * 64 + m * 16 + fr; const float rs = row_rs16(SS, row, 1.0f / 1024.0f);
#pragma unroll
                for (int bj = 0; bj < 2; ++bj) { f32x4 a = acc[ai][bj][m][0] * rs, b = acc[ai][bj][m][1] * rs;
#pragma unroll
                    for (int j = 0; j < 4; ++j) { a[j] = fmaxf(a[j], 0.f); b[j] = fmaxf(b[j], 0.f); }
                    *(u32x4*)(ACT + (size_t)row * 4096 + u.pn * BM + bj * HALF + wc * 32 + 8 * fq) = pack8(a * a, b * b); }
            }
    }
};
struct EpiDown { static constexpr bool PERM = true, AFTER_DRAIN = false;
    const float* SS; bf16_t *CQ, *CKV, *KR; float *SSQ, *SSKV; const float *cosC, *sinC;
    __device__ __forceinline__ void operator()(const f32x4 (&acc)[2][2][4][2], const Unit& u, int wr, int wc, int fr, int fq) const {
#pragma unroll
        for (int ai = 0; ai < 2; ++ai)
#pragma unroll
            for (int m = 0; m < 4; ++m) {
                const int row = u.pm * BM + ai * HALF + wr * 64 + m * 16 + fr; const float rs = row_rs16(SS, row, 1.0f / 1024.0f);
                f32x4 v[2][2];
#pragma unroll
                for (int bj = 0; bj < 2; ++bj)
#pragma unroll
                    for (int n = 0; n < 2; ++n) v[bj][n] = acc[ai][bj][m][n] * rs;
                if (u.pn == 0) {
                    float ss = 0.f;
#pragma unroll
                    for (int bj = 0; bj < 2; ++bj) { *(u32x4*)(CQ + (size_t)row * 256 + bj * HALF + wc * 32 + 8 * fq) = pack8(v[bj][0], v[bj][1]); ss += hsum4(v[bj][0] * v[bj][0]) + hsum4(v[bj][1] * v[bj][1]); }
                    ss = quad_sum(ss); if (fq == 0) SSQ[(size_t)row * 4 + wc] = ss;
                } else {
                    *(u32x4*)(CKV + (size_t)row * 128 + wc * 32 + 8 * fq) = pack8(v[0][0], v[0][1]);
                    float ss = hsum4(v[0][0] * v[0][0]) + hsum4(v[0][1] * v[0][1]); ss = quad_sum(ss); if (fq == 0) SSKV[(size_t)row * 4 + wc] = ss;
                    if (wc == 0) {
                        const int t = row & 2047, i0 = 8 * (fq & 1); f32x4 o[2];
#pragma unroll
                        for (int n = 0; n < 2; ++n) { const f32x4 x = v[1][n]; f32x4 y;
#pragma unroll
                            for (int j = 0; j < 4; ++j) y[j] = __shfl_xor(x[j], 32);
                            const f32x4 c = *(const f32x4*)(cosC + t * 16 + i0 + 4 * n), s = *(const f32x4*)(sinC + t * 16 + i0 + 4 * n);
                            o[n] = (fq < 2) ? (x * c - y * s) : (x * c + y * s); }
                        *(u32x4*)(KR + (size_t)row * 32 + 8 * fq) = pack8(o[0], o[1]);
                    }
                }
            }
    }
};
struct EpiUpQ { static constexpr bool PERM = true, AFTER_DRAIN = false;
    const float* SSQ; bf16_t *QN, *QR; const float *cosC, *sinC;
    __device__ __forceinline__ void operator()(const f32x4 (&acc)[2][2][4][2], const Unit& u, int wr, int wc, int fr, int fq) const {
#pragma unroll
        for (int ai = 0; ai < 2; ++ai)
#pragma unroll
            for (int m = 0; m < 4; ++m) {
                const int row = u.pm * BM + ai * HALF + wr * 64 + m * 16 + fr; const float rs = row_rs4(SSQ, row, 1.0f / 256.0f);
                f32x4 v[2][2];
#pragma unroll
                for (int bj = 0; bj < 2; ++bj)
#pragma unroll
                    for (int n = 0; n < 2; ++n) v[bj][n] = acc[ai][bj][m][n] * rs;
                if (u.pn < 4) {
#pragma unroll
                    for (int bj = 0; bj < 2; ++bj) *(u32x4*)(QN + (size_t)row * 1024 + u.pn * BM + bj * HALF + wc * 32 + 8 * fq) = pack8(v[bj][0], v[bj][1]);
                } else {
                    const int t = row & 2047, head = 8 * (u.pn - 4) + 2 * wc + (fq >> 1), i0 = 8 * (fq & 1);
#pragma unroll
                    for (int n = 0; n < 2; ++n) { const f32x4 c = *(const f32x4*)(cosC + t * 16 + i0 + 4 * n), s = *(const f32x4*)(sinC + t * 16 + i0 + 4 * n);
                        const f32x4 x1 = v[0][n], x2 = v[1][n]; v[0][n] = x1 * c - x2 * s; v[1][n] = x2 * c + x1 * s; }
#pragma unroll
                    for (int bj = 0; bj < 2; ++bj) *(u32x4*)(QR + (size_t)row * 512 + head * 32 + 16 * bj + i0) = pack8(v[bj][0], v[bj][1]);
                }
            }
    }
};
struct EpiUpKV { static constexpr bool PERM = true, AFTER_DRAIN = false;
    const float* SSKV; bf16_t *KN, *VC;
    __device__ __forceinline__ void operator()(const f32x4 (&acc)[2][2][4][2], const Unit& u, int wr, int wc, int fr, int fq) const {
        bf16_t* dstb = (u.pn < 4 ? KN : VC) + (u.pn & 3) * BM + wc * 32 + 8 * fq;
#pragma unroll
        for (int ai = 0; ai < 2; ++ai)
#pragma unroll
            for (int m = 0; m < 4; ++m) {
                const int row = u.pm * BM + ai * HALF + wr * 64 + m * 16 + fr; const float rs = row_rs4(SSKV, row, 1.0f / 128.0f);
#pragma unroll
                for (int bj = 0; bj < 2; ++bj) *(u32x4*)(dstb + (size_t)row * 1024 + bj * HALF) = pack8(acc[ai][bj][m][0] * rs, acc[ai][bj][m][1] * rs);
            }
    }
};


template <class Epi, class Sched, bool ALIGN_EPI = false, bool SP2 = false>
__device__ __forceinline__ void gemm_phase(PG8_LAS unsigned char* lds, const Gemm g, const Sched& S, const Epi& E) {
    int tid_ = threadIdx.x; asm volatile("" : "+v"(tid_));
    const int tid = tid_, wid = __builtin_amdgcn_readfirstlane(tid >> 6), lane = tid & 63, wr = wid >> 2, wc = wid & 3, fr = lane & 15, fq = lane >> 4;
    const int K = g.K, nt = K / BK;
    unsigned voffA[2], voffB[2];
#pragma unroll
    for (int i = 0; i < 2; ++i) { int R, C; stage_rc(tid * 16 + i * 8192, R, C); const int Rb = Epi::PERM ? ((R & ~31) + perm32(R & 31)) : R;
        voffA[i] = (unsigned)(R * K + C) * 2u; voffB[i] = (unsigned)(Rb * K + C) * 2u; }
    const size_t kstep = (size_t)(BK * 2);
    const size_t hstep = (size_t)HALF * K * 2;
    const size_t tstep = 2 * hstep;
    const unsigned ldsw = (unsigned)wid * 1024u;
    const int aoff = lds_byte(wr * 64 + fr, fq * 8), boff = lds_byte(wc * 32 + fr, fq * 8);
#define PG8_SA(b, h) (((b) * 2 + (h)) * HTB)
#define PG8_SB(b, h) ((4 + (b) * 2 + (h)) * HTB)
#define PG8_STAGE(bufoff, gbase, voff) do { _Pragma("unroll") for (int _i = 0; _i < 2; ++_i) \
        __builtin_amdgcn_global_load_lds((const unsigned*)((const char*)(gbase) + (voff)[_i]), (PG8_LAS unsigned*)(lds + (bufoff) + ldsw + _i * 8192), 16, 0, 0); } while (0)
#define PG8_LDA(dst, b, h) do { _Pragma("unroll") for (int m = 0; m < 4; ++m) _Pragma("unroll") for (int k = 0; k < 2; ++k) dst[m][k] = *(const PG8_LAS bf16x8*)(lds + PG8_SA(b, h) + aoff + m * 2048 + k * 1024); } while (0)
#define PG8_LDB(dst, b, h) do { _Pragma("unroll") for (int n = 0; n < 2; ++n) _Pragma("unroll") for (int k = 0; k < 2; ++k) dst[n][k] = *(const PG8_LAS bf16x8*)(lds + PG8_SB(b, h) + boff + n * 2048 + k * 1024); } while (0)
#define PG8_MMA(ai, bj, At, Bt) do { __builtin_amdgcn_s_setprio(1); _Pragma("unroll") for (int m = 0; m < 4; ++m) _Pragma("unroll") for (int n = 0; n < 2; ++n) _Pragma("unroll") for (int k = 0; k < 2; ++k) \
        acc[ai][bj][m][n] = __builtin_amdgcn_mfma_f32_16x16x32_bf16(Bt[n][k], At[m][k], acc[ai][bj][m][n], 0, 0, 0); __builtin_amdgcn_s_setprio(0); } while (0)
#define PG8_WAIT_V(n) asm volatile("s_waitcnt vmcnt(" #n ")" ::: "memory")
#define PG8_WAIT_L(n) asm volatile("s_waitcnt lgkmcnt(" #n ")" ::: "memory")
#define PG8_BAR __builtin_amdgcn_s_barrier()
#define PG8_SCHED __builtin_amdgcn_sched_barrier(0)
    Unit cur, nxt; int ui = 0;
    if (!S.next(0, cur)) return;
    f32x4 acc[2][2][4][2];
#pragma unroll
    for (int a = 0; a < 2; ++a)
#pragma unroll
        for (int b = 0; b < 2; ++b)
#pragma unroll
            for (int m = 0; m < 4; ++m)
#pragma unroll
                for (int n = 0; n < 2; ++n) acc[a][b][m][n] = (f32x4){0.f, 0.f, 0.f, 0.f};
    bf16x8 At[4][2], B0[2][2], B1[2][2];
    const char* cA = (const char*)g.A + (size_t)cur.pm * tstep; const char* cB = (const char*)g.Bt + (size_t)cur.pn * tstep;
    S.a_ready(cur);
    if constexpr (SP2) {
        PG8_STAGE(PG8_SB(0, 0), cB, voffB); PG8_STAGE(PG8_SB(0, 1), cB + hstep, voffB); PG8_STAGE(PG8_SA(0, 0), cA, voffA); PG8_STAGE(PG8_SA(0, 1), cA + hstep, voffA);
        if (wr == 1) PG8_BAR;
        PG8_WAIT_V(2); PG8_BAR;
        PG8_STAGE(PG8_SB(1, 0), cB + kstep, voffB); PG8_STAGE(PG8_SA(1, 0), cA + kstep, voffA); PG8_STAGE(PG8_SB(1, 1), cB + hstep + kstep, voffB);
        PG8_WAIT_V(6); PG8_BAR;
    } else {
        PG8_STAGE(PG8_SB(0, 0), cB, voffB); PG8_STAGE(PG8_SA(0, 0), cA, voffA); PG8_STAGE(PG8_SB(0, 1), cB + hstep, voffB); PG8_STAGE(PG8_SA(0, 1), cA + hstep, voffA);
        if (wr == 1) PG8_BAR;
        PG8_WAIT_V(4); PG8_BAR;
        PG8_STAGE(PG8_SB(1, 0), cB + kstep, voffB); PG8_STAGE(PG8_SA(1, 0), cA + kstep, voffA); PG8_STAGE(PG8_SB(1, 1), cB + hstep + kstep, voffB);
        PG8_WAIT_V(6); PG8_BAR;
    }
    for (;;) {
        const bool has_next = S.next(ui + 1, nxt);
        const char* nA = has_next ? (const char*)g.A + (size_t)nxt.pm * tstep : cA; const char* nB = has_next ? (const char*)g.Bt + (size_t)nxt.pn * tstep : cB;
        for (int t = 0; t < nt; t += 2) {
            const bool last = (t == nt - 2);
            const char* a1 = cA + (size_t)(t + 1) * kstep;
            const char* a2 = last ? nA : cA + (size_t)(t + 2) * kstep; const char* b2 = last ? nB : cB + (size_t)(t + 2) * kstep;
            const char* a3 = a2 + kstep; const char* b3 = b2 + kstep;
            if (last && has_next) S.a_ready(nxt);
            if constexpr (SP2) {
            PG8_LDB(B0, 0, 0); PG8_LDB(B1, 0, 1); PG8_SCHED; PG8_LDA(At, 0, 0); PG8_STAGE(PG8_SA(1, 1), a1 + hstep, voffA);
            PG8_WAIT_V(8); PG8_WAIT_L(0); PG8_BAR; PG8_MMA(0, 0, At, B0); PG8_MMA(0, 1, At, B1); PG8_BAR; PG8_SCHED;
            PG8_LDA(At, 0, 1); PG8_STAGE(PG8_SB(0, 0), b2, voffB); PG8_STAGE(PG8_SB(0, 1), b2 + hstep, voffB); PG8_STAGE(PG8_SA(0, 0), a2, voffA);
            PG8_WAIT_V(8); PG8_WAIT_L(0); PG8_BAR; PG8_MMA(1, 0, At, B0); PG8_MMA(1, 1, At, B1); PG8_BAR; PG8_SCHED;
            PG8_LDB(B0, 1, 0); PG8_LDB(B1, 1, 1); PG8_SCHED; PG8_LDA(At, 1, 0); PG8_STAGE(PG8_SA(0, 1), a2 + hstep, voffA);
            PG8_WAIT_V(8); PG8_WAIT_L(0); PG8_BAR; PG8_MMA(0, 0, At, B0); PG8_MMA(0, 1, At, B1); PG8_BAR; PG8_SCHED;
            PG8_LDA(At, 1, 1); PG8_STAGE(PG8_SB(1, 0), b3, voffB); PG8_STAGE(PG8_SB(1, 1), b3 + hstep, voffB); PG8_STAGE(PG8_SA(1, 0), a3, voffA);
            PG8_WAIT_V(8); PG8_WAIT_L(0); PG8_BAR; PG8_MMA(1, 0, At, B0); PG8_MMA(1, 1, At, B1); PG8_BAR; PG8_SCHED;
            } else {
            PG8_LDB(B0, 0, 0); PG8_SCHED; PG8_LDA(At, 0, 0); PG8_STAGE(PG8_SA(1, 1), a1 + hstep, voffA);
            PG8_WAIT_L(8); PG8_BAR; PG8_WAIT_L(0); PG8_MMA(0, 0, At, B0); PG8_BAR; PG8_SCHED;
            PG8_LDB(B1, 0, 1); PG8_STAGE(PG8_SB(0, 0), b2, voffB);
            PG8_BAR; PG8_WAIT_L(0); PG8_MMA(0, 1, At, B1); PG8_BAR;
            PG8_LDA(At, 0, 1); PG8_STAGE(PG8_SA(0, 0), a2, voffA);
            PG8_BAR; PG8_WAIT_L(0); PG8_MMA(1, 0, At, B0); PG8_BAR; PG8_SCHED;
            PG8_STAGE(PG8_SB(0, 1), b2 + hstep, voffB);
            PG8_WAIT_V(6); PG8_BAR; PG8_MMA(1, 1, At, B1); PG8_BAR;
            PG8_LDB(B0, 1, 0); PG8_SCHED; PG8_LDA(At, 1, 0); PG8_STAGE(PG8_SA(0, 1), a2 + hstep, voffA);
            PG8_WAIT_L(8); PG8_BAR; PG8_WAIT_L(0); PG8_MMA(0, 0, At, B0); PG8_BAR; PG8_SCHED;
            PG8_LDB(B1, 1, 1); PG8_STAGE(PG8_SB(1, 0), b3, voffB);
            PG8_BAR; PG8_WAIT_L(0); PG8_MMA(0, 1, At, B1); PG8_BAR;
            PG8_LDA(At, 1, 1); PG8_STAGE(PG8_SA(1, 0), a3, voffA);
            PG8_BAR; PG8_WAIT_L(0); PG8_MMA(1, 0, At, B0); PG8_BAR; PG8_SCHED;
            PG8_STAGE(PG8_SB(1, 1), b3 + hstep, voffB);
            PG8_WAIT_V(6); PG8_BAR; PG8_MMA(1, 1, At, B1); PG8_BAR;
            }
        }
        if constexpr (ALIGN_EPI) { if (wr == 0) PG8_BAR; }
        if constexpr (!Epi::AFTER_DRAIN) { E(acc, cur, wr, wc, fr, fq); S.done(cur); }
        if (!has_next) break;
#pragma unroll
        for (int a = 0; a < 2; ++a)
#pragma unroll
            for (int b = 0; b < 2; ++b)
#pragma unroll
                for (int m = 0; m < 4; ++m)
#pragma unroll
                    for (int n = 0; n < 2; ++n) acc[a][b][m][n] = (f32x4){0.f, 0.f, 0.f, 0.f};
        cur = nxt; cA = nA; cB = nB; ++ui;
        if constexpr (ALIGN_EPI) { if (wr == 1) PG8_BAR; }
    }
    PG8_WAIT_V(0);
    if constexpr (!ALIGN_EPI) { if (wr == 0) PG8_BAR; }
    PG8_BAR;
    if constexpr (Epi::AFTER_DRAIN) { E.fused(acc, cur, wr, wc, fr, fq, lds, wid, lane); S.done(cur); }
#undef PG8_SA
#undef PG8_SB
#undef PG8_STAGE
#undef PG8_LDA
#undef PG8_LDB
#undef PG8_MMA
#undef PG8_WAIT_V
#undef PG8_WAIT_L
#undef PG8_BAR
#undef PG8_SCHED
}
}

namespace attn {
using bf16x8 = __attribute__((ext_vector_type(8))) short;
using s16x4  = __attribute__((ext_vector_type(4))) short;
using f32x16 = __attribute__((ext_vector_type(16))) float;
using u32x4  = __attribute__((ext_vector_type(4))) unsigned;
typedef unsigned short bf16;
#define SBAR() __builtin_amdgcn_sched_barrier(0)
constexpr float THR = 8.f;
__device__ __forceinline__ int crow(int r, int hi) { return (r & 3) + 8 * (r >> 2) + 4 * hi; }
__device__ __forceinline__ unsigned cvtpk(float lo, float hi) { unsigned r; asm volatile("v_cvt_pk_bf16_f32 %0, %1, %2" : "=v"(r) : "v"(lo), "v"(hi)); return r; }
__device__ __forceinline__ bf16x8 ld8(const bf16* p) { return *reinterpret_cast<const bf16x8*>(p); }
template <int KP> __device__ __forceinline__ int kswz(int row, int colB) { return KP == 128 ? row * 128 + (colB ^ (((row >> 1) & 7) << 4)) : row * 256 + (colB ^ ((row & 15) << 4)); }

template <int SC1000> __device__ __forceinline__ void partialSM(f32x16& p0, f32x16& p1, float& m_reg, float& mn, float& alpha, const float SCALE) {
  const float C = SCALE * 1.4426950408889634f;
  float pmax = p0[0];
#pragma unroll
  for (int r = 1; r < 16; ++r) pmax = fmaxf(pmax, p0[r]);
#pragma unroll
  for (int r = 0; r < 16; ++r) pmax = fmaxf(pmax, p1[r]);
  { auto rr = __builtin_amdgcn_permlane32_swap(__float_as_uint(pmax), __float_as_uint(pmax), false, false);
    pmax = fmaxf(__uint_as_float(rr[0]), __uint_as_float(rr[1])); }
  if (__builtin_expect(__all(pmax - m_reg <= THR / SCALE), 1)) { mn = m_reg; alpha = 1.f; }
  else { mn = fmaxf(m_reg, pmax); alpha = __builtin_amdgcn_exp2f((m_reg - mn) * C); m_reg = mn; }
  const float mnC = -mn * C;
#pragma unroll
  for (int r = 0; r < 16; ++r) p0[r] = fmaf(p0[r], C, mnC);
#pragma unroll
  for (int r = 0; r < 16; ++r) p1[r] = fmaf(p1[r], C, mnC);
#pragma unroll
  for (int r = 0; r < 16; ++r) p0[r] = __builtin_amdgcn_exp2f(p0[r]);
}
#define ATT_PK4(P, BASE, OUT) do { unsigned a0 = cvtpk(P[BASE + 0], P[BASE + 1]), a1 = cvtpk(P[BASE + 2], P[BASE + 3]);   \
    unsigned b0 = cvtpk(P[BASE + 4], P[BASE + 5]), b1 = cvtpk(P[BASE + 6], P[BASE + 7]);                              \
    auto r0 = __builtin_amdgcn_permlane32_swap(a0, b0, false, false); auto r1 = __builtin_amdgcn_permlane32_swap(a1, b1, false, false); \
    u32x4 w = {r0[0], r1[0], r0[1], r1[1]}; OUT = *reinterpret_cast<bf16x8*>(&w); } while (0)
__device__ __forceinline__ void finishSM(f32x16& p0, f32x16& p1, float alpha, float& l_reg, bf16x8& pa0, bf16x8& pa1, bf16x8& pa2, bf16x8& pa3) {
#pragma unroll
  for (int r = 0; r < 16; ++r) p1[r] = __builtin_amdgcn_exp2f(p1[r]);
  float ps = 0;
#pragma unroll
  for (int r = 0; r < 16; ++r) ps += p0[r];
#pragma unroll
  for (int r = 0; r < 16; ++r) ps += p1[r];
  { auto rr = __builtin_amdgcn_permlane32_swap(__float_as_uint(ps), __float_as_uint(ps), false, false);
    ps = __uint_as_float(rr[0]) + __uint_as_float(rr[1]); }
  l_reg = l_reg * alpha + ps;
  ATT_PK4(p0, 0, pa0); ATT_PK4(p0, 8, pa1); ATT_PK4(p1, 0, pa2); ATT_PK4(p1, 8, pa3);
}
template <int ND0, int KP> __device__ __forceinline__ void qkt(f32x16& p0, f32x16& p1, const char* Ks, const bf16x8* qr, int r32, int hi) {
  p0 = f32x16{}; p1 = f32x16{};
#pragma unroll
  for (int d0 = 0; d0 < ND0; ++d0) { const int cb = (d0 * 16 + hi * 8) * 2;
    const bf16x8 b0 = *reinterpret_cast<const bf16x8*>(Ks + kswz<KP>(r32, cb));
    const bf16x8 b1 = *reinterpret_cast<const bf16x8*>(Ks + kswz<KP>(32 + r32, cb));
    p0 = __builtin_amdgcn_mfma_f32_32x32x16_bf16(b0, qr[d0], p0, 0, 0, 0);
    p1 = __builtin_amdgcn_mfma_f32_32x32x16_bf16(b1, qr[d0], p1, 0, 0, 0); }
}
__device__ __forceinline__ int v_st(int k, int c) { const int kk = (k & ~0xC) | ((k & 4) << 1) | ((k & 8) >> 1); return ((kk >> 3) * 2 + (c >> 5)) * 512 + ((kk & 7) * 32 + (c & 31)) * 2; }
__device__ __forceinline__ int v_rd_base(int lane) { return ((lane & 3) << 3) | (((lane >> 2) & 3) << 6) | (((lane >> 4) & 1) << 5) | (((lane >> 5) & 1) << 8); }
constexpr int v_rd_off(int d0, int ks, int half) { return d0 * 512 + ks * 2048 + half * 1024; }
template <int OFF> __device__ __forceinline__ s16x4 tr_read(int vb) {
  s16x4 r; asm volatile("ds_read_b64_tr_b16 %0, %1 offset:%2" : "=&v"(r) : "v"(vb), "i"(OFF) : "memory"); return r;
}
#define ATT_PK(L, H) (bf16x8){L[0], L[1], L[2], L[3], H[0], H[1], H[2], H[3]}
template <int D0> __device__ __forceinline__ void pv_one(f32x16& od, int vb, bf16x8 pa0, bf16x8 pa1, bf16x8 pa2, bf16x8 pa3) {
  const s16x4 l0 = tr_read<v_rd_off(D0, 0, 0)>(vb), h0 = tr_read<v_rd_off(D0, 0, 1)>(vb), l1 = tr_read<v_rd_off(D0, 1, 0)>(vb), h1 = tr_read<v_rd_off(D0, 1, 1)>(vb);
  const s16x4 l2 = tr_read<v_rd_off(D0, 2, 0)>(vb), h2 = tr_read<v_rd_off(D0, 2, 1)>(vb), l3 = tr_read<v_rd_off(D0, 3, 0)>(vb), h3 = tr_read<v_rd_off(D0, 3, 1)>(vb);
  asm volatile("s_waitcnt lgkmcnt(0)" ::: "memory"); SBAR();
  od = __builtin_amdgcn_mfma_f32_32x32x16_bf16(pa0, ATT_PK(l0, h0), od, 0, 0, 0);
  od = __builtin_amdgcn_mfma_f32_32x32x16_bf16(pa1, ATT_PK(l1, h1), od, 0, 0, 0);
  od = __builtin_amdgcn_mfma_f32_32x32x16_bf16(pa2, ATT_PK(l2, h2), od, 0, 0, 0);
  od = __builtin_amdgcn_mfma_f32_32x32x16_bf16(pa3, ATT_PK(l3, h3), od, 0, 0, 0);
}
__device__ __forceinline__ void pv_d0(f32x16* o, int vb, bf16x8 pa0, bf16x8 pa1, bf16x8 pa2, bf16x8 pa3) {
  pv_one<0>(o[0], vb, pa0, pa1, pa2, pa3); pv_one<1>(o[1], vb, pa0, pa1, pa2, pa3);
}
template <int DQK>
__device__ __forceinline__ void dense_unit(const bf16* __restrict__ Q1, int ldq1, const bf16* __restrict__ Q2, int ldq2, const bf16* __restrict__ K1, int ldk1, const bf16* __restrict__ K2, int ldk2,
                                           const bf16* __restrict__ V, int ldv, bf16* __restrict__ O, int ldo, int seq, char* lds) {
  constexpr int ND0 = DQK / 16, KP = DQK == 64 ? 128 : 256, SHM_V = 64 * 64 * 2, SHM_K = 64 * KP;
  constexpr float SCALE = DQK == 64 ? 0.125f : 0.10206207261596575f;
  int tid_ = threadIdx.x; asm volatile("" : "+v"(tid_));
  const int tid = tid_, wid = tid >> 6, lane = tid & 63, r32 = lane & 31, hi = lane >> 5;
  char* V_lds = lds; char* K_lds = lds + 2 * SHM_V;
  float* wsf = (float*)(lds + 2 * SHM_V + 2 * SHM_K) + wid * 64; float* li_l = wsf; float* al_l = wsf + 32;
  float m_reg = -1e30f, l_reg = 0; f32x16 o[2] = {}; bf16x8 qr[ND0];
  { const bf16* Qw1 = Q1 + (long)(wid * 32 + r32) * ldq1 + hi * 8;
#pragma unroll
    for (int d0 = 0; d0 < 4; ++d0) qr[d0] = ld8(Qw1 + d0 * 16);
    if constexpr (DQK == 96) { const bf16* Qw2 = Q2 + (long)(wid * 32 + r32) * ldq2 + hi * 8; qr[4] = ld8(Qw2); qr[5] = ld8(Qw2 + 16); } }
  const int sr = tid >> 3, sc = (tid & 7) * 8, vst0 = v_st(sr, sc), kst1 = kswz<KP>(sr, sc * 2);
  const int sr2 = (tid & 255) >> 2, sc2 = (tid & 3) * 8, kst2 = kswz<KP>(sr2, (64 + sc2) * 2); const bool k2w = (DQK == 96) && (wid < 4);
  const int vb0 = (int)(uintptr_t)V_lds + v_rd_base(lane);
  bf16x8 svA, skA, sk2A = {}, svB, skB, sk2B = {};
#define ATT_SLOAD(SV, SK, SK2, k0) do { SV = ld8(&V[(long)((k0) + sr) * ldv + sc]); SK = ld8(&K1[(long)((k0) + sr) * ldk1 + sc]); if (k2w) SK2 = ld8(&K2[(long)((k0) + sr2) * ldk2 + sc2]); } while (0)
#define ATT_SWRITE(b, SV, SK, SK2) do { *(bf16x8*)(V_lds + (b) * SHM_V + vst0) = SV; *(bf16x8*)(K_lds + (b) * SHM_K + kst1) = SK; if (k2w) *(bf16x8*)(K_lds + (b) * SHM_K + kst2) = SK2; } while (0)
#define ATT_RESC(a) do { if (__any((a) < 1.f)) { if (hi == 0) al_l[r32] = (a); asm volatile("s_waitcnt lgkmcnt(0)" ::: "memory"); \
    _Pragma("unroll") for (int d = 0; d < 2; ++d) _Pragma("unroll") for (int r = 0; r < 16; ++r) o[d][r] *= al_l[crow(r, hi)]; } } while (0)
  f32x16 pA0, pA1, pB0, pB1; float mnA, mnB, alA, alB; bf16x8 pa0, pa1, pa2, pa3; const int NT = seq / 64;
  ATT_SLOAD(svA, skA, sk2A, 0); ATT_SWRITE(0, svA, skA, sk2A); __syncthreads();
  qkt<ND0, KP>(pA0, pA1, K_lds, qr, r32, hi); partialSM<0>(pA0, pA1, m_reg, mnA, alA, SCALE);
  ATT_SLOAD(svB, skB, sk2B, 64); if (2 < NT) ATT_SLOAD(svA, skA, sk2A, 128);
  ATT_SWRITE(1, svB, skB, sk2B); __syncthreads();
  for (int j = 1; j + 1 < NT; j += 2) {
    SBAR(); qkt<ND0, KP>(pB0, pB1, K_lds + SHM_K, qr, r32, hi);
    finishSM(pA0, pA1, alA, l_reg, pa0, pa1, pa2, pa3); SBAR();
    ATT_SLOAD(svB, skB, sk2B, (j + 2) * 64); SBAR();
    pv_d0(o, vb0, pa0, pa1, pa2, pa3); partialSM<0>(pB0, pB1, m_reg, mnB, alB, SCALE);
    __syncthreads(); ATT_SWRITE(0, svA, skA, sk2A);
    ATT_RESC(alB); __syncthreads();
    SBAR(); qkt<ND0, KP>(pA0, pA1, K_lds, qr, r32, hi);
    finishSM(pB0, pB1, alB, l_reg, pa0, pa1, pa2, pa3); SBAR();
    if (j + 3 < NT) ATT_SLOAD(svA, skA, sk2A, (j + 3) * 64); SBAR();
    pv_d0(o, vb0 + SHM_V, pa0, pa1, pa2, pa3); partialSM<0>(pA0, pA1, m_reg, mnA, alA, SCALE);
    __syncthreads(); ATT_SWRITE(1, svB, skB, sk2B);
    ATT_RESC(alA); __syncthreads();
  }
  SBAR(); qkt<ND0, KP>(pB0, pB1, K_lds + SHM_K, qr, r32, hi);
  finishSM(pA0, pA1, alA, l_reg, pa0, pa1, pa2, pa3); SBAR();
  pv_d0(o, vb0, pa0, pa1, pa2, pa3); partialSM<0>(pB0, pB1, m_reg, mnB, alB, SCALE);
  __syncthreads(); ATT_RESC(alB);
  finishSM(pB0, pB1, alB, l_reg, pa0, pa1, pa2, pa3); SBAR();
  pv_d0(o, vb0 + SHM_V, pa0, pa1, pa2, pa3);
  if (hi == 0) li_l[r32] = l_reg; asm volatile("s_waitcnt lgkmcnt(0)" ::: "memory");
  float rli[16];
#pragma unroll
  for (int r = 0; r < 16; ++r) rli[r] = __builtin_amdgcn_rcpf(li_l[crow(r, hi)]);
  bf16* Ow = O + (long)(wid * 32) * ldo;
#pragma unroll
  for (int r = 0; r < 16; ++r) { const int orow = crow(r, hi);
#pragma unroll
    for (int d0 = 0; d0 < 2; ++d0) { const unsigned w = cvtpk(o[d0][r] * rli[r], 0.f); Ow[(long)orow * ldo + d0 * 32 + r32] = (bf16)(w & 0xffffu); } }
#undef ATT_SLOAD
#undef ATT_SWRITE
#undef ATT_RESC
}
constexpr int DENSE_LDS_BYTES = 2 * 8192 + 2 * 64 * 256 + 8 * 64 * 4;
}

namespace dil {
using attn::bf16x8; using attn::s16x4; using attn::f32x16; using attn::u32x4; using attn::crow; using attn::cvtpk; using attn::ld8; using attn::v_st; using attn::v_rd_base; using attn::tr_read;
typedef unsigned short bf16;
constexpr int LDP = 2304;
constexpr int OFF_OACC = 0, OFF_MX = 65536, OFF_LS = 66560, OFF_BIAS = 67584, OFF_WS = 69888, OFF_VST = 73728, LDS_BYTES = OFF_VST + 8 * 4096;
constexpr float LOG2E = 1.4426950408889634f, C2 = 0.125f * LOG2E, NEGBIG = -1e30f;

template <int BR>
__device__ __forceinline__ void item(const bf16* __restrict__ Qb, const bf16* __restrict__ Kb, const bf16* __restrict__ Vb, bf16* __restrict__ Ob, int r, int u0, int tl0, char* lds, int wid, int lane) {
  constexpr int DIL = BR == 0 ? 1 : (BR == 1 ? 4 : 16), SU = 2048 / DIL, NQ = BR == 2 ? 16 : 32, NR = BR == 2 ? 8 : 16;
  asm volatile("" : "+v"(lane));
  const int r32 = lane & 31, hi = lane >> 5;
  float* OACC = (float*)(lds + OFF_OACC); float* MX = (float*)(lds + OFF_MX); float* LS = (float*)(lds + OFF_LS);
  const float* BIASP = (const float*)(lds + OFF_BIAS) + BR * 192; float* wsf = (float*)(lds + OFF_WS) + wid * 64; char* Vst = lds + OFF_VST + wid * 4096;
  bf16x8 qr[4];
  { int pq = r + DIL * (u0 + r32); pq = pq > 2047 ? 2047 : pq; const bf16* qp = Qb + (long)pq * LDP + hi * 8;
#pragma unroll
    for (int d0 = 0; d0 < 4; ++d0) qr[d0] = ld8(qp + d0 * 16); }
  const int kbase = u0 - 64;
  f32x16 s[5];
  bf16x8 kf[2][4];
#define DIL_KLOAD(buf, kb) do { int uk_ = kbase + 32 * (kb) + r32; uk_ = uk_ < 0 ? 0 : (uk_ > SU - 1 ? SU - 1 : uk_); const bf16* kp_ = Kb + (long)(r + DIL * uk_) * LDP + hi * 8; \
    _Pragma("unroll") for (int d0 = 0; d0 < 4; ++d0) kf[buf][d0] = ld8(kp_ + d0 * 16); } while (0)
  DIL_KLOAD(0, 0);
#pragma unroll
  for (int kb = 0; kb < 5; ++kb) {
    if (kb + 1 < 5) DIL_KLOAD((kb + 1) & 1, kb + 1);
    s[kb] = f32x16{};
#pragma unroll
    for (int d0 = 0; d0 < 4; ++d0) s[kb] = __builtin_amdgcn_mfma_f32_32x32x16_bf16(kf[kb & 1][d0], qr[d0], s[kb], 0, 0, 0);
    SBAR();
  }
#undef DIL_KLOAD
  const float* bp = BIASP + 32 - r32; const int lo = -kbase, hl = SU - kbase;
  float mx = NEGBIG;
#pragma unroll
  for (int kb = 0; kb < 5; ++kb) {
#pragma unroll
    for (int rr = 0; rr < 16; ++rr) { const int kk = 32 * kb + crow(rr, hi); float v = fmaf(s[kb][rr], C2, bp[kk]); v = (kk >= lo && kk < hl) ? v : NEGBIG; s[kb][rr] = v; mx = fmaxf(mx, v); }
    SBAR(); }
  { auto sw = __builtin_amdgcn_permlane32_swap(__float_as_uint(mx), __float_as_uint(mx), false, false); mx = fmaxf(__uint_as_float(sw[0]), __uint_as_float(sw[1])); }
  float l = 0.f;
#pragma unroll
  for (int kb = 0; kb < 5; ++kb)
#pragma unroll
    for (int rr = 0; rr < 16; ++rr) { const float p = __builtin_amdgcn_exp2f(s[kb][rr] - mx); s[kb][rr] = p; l += p; }
  { auto sw = __builtin_amdgcn_permlane32_swap(__float_as_uint(l), __float_as_uint(l), false, false); l = __uint_as_float(sw[0]) + __uint_as_float(sw[1]); }
  f32x16 o[2] = {};
  const int vkey = lane >> 3, vcol = (lane & 7) * 8; const int vb = (int)(uintptr_t)Vst + v_rd_base(lane);
  bf16x8 vr[2][4];
#define DIL_VLOAD(buf, kb) do { _Pragma("unroll") for (int i = 0; i < 4; ++i) { int uk_ = kbase + 32 * (kb) + vkey + 8 * i; uk_ = uk_ < 0 ? 0 : (uk_ > SU - 1 ? SU - 1 : uk_); vr[buf][i] = ld8(Vb + (long)(r + DIL * uk_) * LDP + vcol); } } while (0)
  DIL_VLOAD(0, 0);
#pragma unroll
  for (int kb = 0; kb < 5; ++kb) {
    if (kb + 1 < 5) DIL_VLOAD((kb + 1) & 1, kb + 1);
    bf16x8 pa0, pa1; ATT_PK4(s[kb], 0, pa0); ATT_PK4(s[kb], 8, pa1);
#pragma unroll
    for (int i = 0; i < 4; ++i) *(bf16x8*)(Vst + v_st(vkey + 8 * i, vcol)) = vr[kb & 1][i];
    asm volatile("s_waitcnt lgkmcnt(0)" ::: "memory");
    {
      const s16x4 l0 = tr_read<0>(vb), h0 = tr_read<1024>(vb), l1 = tr_read<2048>(vb), h1 = tr_read<3072>(vb);
      const s16x4 m0 = tr_read<512>(vb), g0 = tr_read<512 + 1024>(vb), m1 = tr_read<512 + 2048>(vb), g1 = tr_read<512 + 3072>(vb);
      asm volatile("s_waitcnt lgkmcnt(0)" ::: "memory"); SBAR();
      o[0] = __builtin_amdgcn_mfma_f32_32x32x16_bf16(pa0, ATT_PK(l0, h0), o[0], 0, 0, 0);
      o[0] = __builtin_amdgcn_mfma_f32_32x32x16_bf16(pa1, ATT_PK(l1, h1), o[0], 0, 0, 0);
      o[1] = __builtin_amdgcn_mfma_f32_32x32x16_bf16(pa0, ATT_PK(m0, g0), o[1], 0, 0, 0);
      o[1] = __builtin_amdgcn_mfma_f32_32x32x16_bf16(pa1, ATT_PK(m1, g1), o[1], 0, 0, 0);
    }
    SBAR();
  }
#undef DIL_VLOAD
  { const int tq = tl0 + DIL * r32; const bool vq = r32 < NQ; const int tqc = vq ? tq : 0;
    const float Mo = MX[tqc], Lo = LS[tqc]; const float Mn = fmaxf(Mo, mx);
    float fo = __builtin_amdgcn_exp2f(Mo - Mn), fb = __builtin_amdgcn_exp2f(mx - Mn); const float Ln = Lo * fo + l * fb;
    if (BR == 0) { const float il = __builtin_amdgcn_rcpf(Ln); fo *= il; fb *= il; }
    asm volatile("s_waitcnt lgkmcnt(0)" ::: "memory");
    if (hi == 0) { if (vq && BR != 0) { MX[tq] = Mn; LS[tq] = Ln; } wsf[r32] = fo; wsf[32 + r32] = fb; }
    asm volatile("s_waitcnt lgkmcnt(0)" ::: "memory"); }
#pragma unroll
  for (int rr = 0; rr < NR; ++rr) { const int row = crow(rr, hi); const int tr = tl0 + DIL * row; const float fo = wsf[row], fb = wsf[32 + row];
#pragma unroll
    for (int d0 = 0; d0 < 2; ++d0) { float* pa = OACC + tr * 64 + d0 * 32 + r32; const float val = pa[0] * fo + o[d0][rr] * fb;
      if (BR != 0) pa[0] = val; else { const unsigned w = cvtpk(val, 0.f); Ob[(long)tr * 1024 + d0 * 32 + r32] = (bf16)(w & 0xffffu); } } }
  asm volatile("s_waitcnt lgkmcnt(0)" ::: "memory");
}
__device__ __forceinline__ void unit(const bf16* PROJ, bf16* OAB, const float* relb, const unsigned char* bucket, int b, int h, int sb, char* lds) {
  int tid_ = threadIdx.x; asm volatile("" : "+v"(tid_));
  const int tid = tid_, wid = tid >> 6, lane = tid & 63, T0 = sb * 256;
  { float* OACC = (float*)(lds + OFF_OACC); float* MX = (float*)(lds + OFF_MX); float* LS = (float*)(lds + OFF_LS); float* BIASP = (float*)(lds + OFF_BIAS);
    for (int i = tid; i < 256 * 64; i += 512) OACC[i] = 0.f;
    if (tid < 256) { MX[tid] = NEGBIG; LS[tid] = 0.f; }
    for (int i = tid; i < 3 * 192; i += 512) { const int br = i / 192, j = i % 192 - 32; BIASP[i] = (j >= 0 && j <= 128) ? relb[bucket[br * 129 + j] * 8 + h] * LOG2E : NEGBIG; } }
  __syncthreads();
  const bf16* Qb = PROJ + (size_t)b * 2048 * LDP + 768 + h * 64; const bf16* Kb = Qb + 512; const bf16* Vb = Qb + 1024;
  bf16* Ob = OAB + ((size_t)b * 2048 + T0) * 1024 + 512 + h * 64;
  item<2>(Qb, Kb, Vb, Ob, wid, T0 / 16, wid, lds, wid, lane);
  item<2>(Qb, Kb, Vb, Ob, wid + 8, T0 / 16, wid + 8, lds, wid, lane);
  __syncthreads();
  item<1>(Qb, Kb, Vb, Ob, wid >> 1, T0 / 4 + 32 * (wid & 1), (wid >> 1) + 128 * (wid & 1), lds, wid, lane);
  __syncthreads();
  item<0>(Qb, Kb, Vb, Ob, 0, T0 + 32 * wid, 32 * wid, lds, wid, lane);
  __syncthreads();
}
}

#ifndef MK_N_LAUNCHES
#define MK_N_LAUNCHES 13
#endif
#ifndef MK_NAIVE_MASK
#define MK_NAIVE_MASK 0
#endif
constexpr int NWAVES = 8, NPHASE = 13;
constexpr int N_LAUNCHES = MK_N_LAUNCHES;
static_assert(N_LAUNCHES == 1 || N_LAUNCHES == NPHASE, "MK_N_LAUNCHES is 1 or 13");
constexpr size_t WS_CTL = 0, CTL_ZERO_BYTES = 64 * 1024;
constexpr size_t WS_W_IN = 1 * MiB, WS_W_OUT = 6 * MiB, WS_W_COUT = 8 * MiB, WS_W_DOWN = 10 * MiB, WS_W_UQ = 11 * MiB, WS_W_UKV = 12 * MiB;
constexpr size_t WS_W1_0 = 13 * MiB, WS_W1_1 = 21 * MiB, WS_W2_0 = 29 * MiB, WS_W2_1 = 37 * MiB;
constexpr int CW_BAR = 4096;
constexpr int RING_BYTES = 131072, LDSCTL_OFF = RING_BYTES, MISC_OFF = LDSCTL_OFF + 320, LDS_BYTES = 147456;

#define GAS __attribute__((address_space(1)))
#define LAS __attribute__((address_space(3)))
typedef unsigned v4u __attribute__((ext_vector_type(4)));
typedef float f32x4 __attribute__((ext_vector_type(4)));
typedef GAS unsigned gu32;
#define RLX_AGENT __ATOMIC_RELAXED, __HIP_MEMORY_SCOPE_AGENT
#define LDS_WAIT() asm volatile("s_waitcnt lgkmcnt(0)" ::: "memory")
__device__ __forceinline__ unsigned pk2(float lo, float hi) { return (unsigned)f2bf(lo) | ((unsigned)f2bf(hi) << 16); }


#define XB_TMO      128
#define XB_XCNT(j)  (256  + 64 * (j))
#define XB_XSUB(j)  (1280 + 64 * (j))
#define XB_XGEN(j)  (2304 + 64 * (j))
#define XB_TOP      3328
#define XB_TOPGEN   3392
#define XCD_BAR_WORDS 3456
#define XB_SPIN_CAP (1u << 18)

__device__ __forceinline__ unsigned xb_ld(unsigned* p)              { return __hip_atomic_load(p, __ATOMIC_RELAXED, __HIP_MEMORY_SCOPE_AGENT); }
__device__ __forceinline__ unsigned xb_add(unsigned* p, unsigned v) { return __hip_atomic_fetch_add(p, v, __ATOMIC_RELAXED, __HIP_MEMORY_SCOPE_AGENT); }
__device__ __forceinline__ unsigned xb_xcc_id() { return (unsigned)__builtin_amdgcn_s_getreg((3 << 11) | 20) & 0xFu; }
#define XB_SPIN(cond, bar) do { unsigned _sp = 0; while (cond) { __builtin_amdgcn_s_sleep(1); \
    if ((++_sp & 255u) == 0u) { if (xb_ld(&(bar)[XB_TMO])) break; if (_sp > XB_SPIN_CAP) { atomicAdd(&(bar)[XB_TMO], 1u); break; } } } } while (0)

struct XcdBarrier {
    unsigned* bar; unsigned x;
    volatile LAS unsigned* st;
};

__device__ __forceinline__ XcdBarrier xcd_barrier_post(unsigned* bar, volatile LAS unsigned* st) {
    XcdBarrier b; b.bar = bar; b.x = xb_xcc_id(); b.st = st;
    if (threadIdx.x == 0) (void)xb_add(&bar[XB_XCNT(b.x)], 1u);
    return b;
}
__device__ __forceinline__ void xcd_barrier_complete(unsigned* bar, unsigned x, unsigned& nloc, unsigned& nx) {
    const unsigned G = gridDim.x * gridDim.y * gridDim.z;
    unsigned sum, cnt, mine, sp = 0u;
    for (;;) {
        sum = 0u; cnt = 0u; mine = 0u;
#pragma unroll
        for (unsigned j = 0; j < 16; ++j) { const unsigned c = xb_ld(&bar[XB_XCNT(j)]); sum += c; cnt += (c > 0u) ? 1u : 0u; mine = (j == x) ? c : mine; }
        if (sum == G) break;
        __builtin_amdgcn_s_sleep(1);
        if ((++sp & 255u) == 0u) { if (xb_ld(&bar[XB_TMO])) break; if (sp > XB_SPIN_CAP) { atomicAdd(&bar[XB_TMO], 1u); break; } }
    }
    nloc = mine > 0u ? mine : 1u; nx = cnt > 0u ? cnt : 1u;
}

__device__ __forceinline__ void xcd_barrier(const XcdBarrier& b) {
    asm volatile("s_waitcnt vmcnt(0)" ::: "memory");
    __syncthreads();
    if (threadIdx.x == 0) {
        unsigned* bar = b.bar;
        __builtin_amdgcn_s_waitcnt(0);
        unsigned nloc = b.st[0], nx = b.st[1];
        if (nloc == 0u) { xcd_barrier_complete(bar, b.x, nloc, nx); b.st[0] = nloc; b.st[1] = nx; }
        const unsigned old = xb_add(&bar[XB_XSUB(b.x)], 1u);
        const unsigned gen = old / nloc;
        if (old + 1u == (gen + 1u) * nloc) {
            __builtin_amdgcn_fence(__ATOMIC_RELEASE, "agent");
            asm volatile("s_waitcnt vmcnt(0)" ::: "memory");
            const unsigned og = xb_add(&bar[XB_TOP], 1u);
            const unsigned tg = og / nx;
            if (og + 1u == (tg + 1u) * nx) xb_add(&bar[XB_TOPGEN], 1u);
            else XB_SPIN(xb_ld(&bar[XB_TOPGEN]) == tg, bar);
            __builtin_amdgcn_fence(__ATOMIC_ACQUIRE, "agent");
            xb_add(&bar[XB_XGEN(b.x)], 1u);
            asm volatile("s_waitcnt vmcnt(0)" ::: "memory");
        } else {
            XB_SPIN(xb_ld(&bar[XB_XGEN(b.x)]) == gen, bar);
            __builtin_amdgcn_fence(__ATOMIC_ACQUIRE, "agent");
            asm volatile("s_waitcnt vmcnt(0)" ::: "memory");
        }
    }
    __syncthreads();
}


struct Args { const float* in[17]; float* out; unsigned char* ws; int ph_lo, ph_hi; };
__device__ __forceinline__ float wave_sum(float v) {
#pragma unroll
    for (int o = 1; o < 64; o <<= 1) v += __shfl_xor(v, o);
    return v;
}
__device__ __forceinline__ int prow(int mode, int n) {
    if (mode == 1) return (n & ~255) + 128 * ((n & 63) >> 5) + 32 * ((n & 255) >> 6) + (n & 31);
    if (mode == 2) { const int h = n / 96, dd = n % 96; if (dd < 64) return h * 64 + dd; const int d = dd - 64, hl = h & 7; return 256 * (4 + (h >> 3)) + 128 * (d >> 4) + 32 * (hl >> 1) + (hl & 1) * 16 + (d & 15); }
    if (mode == 3) { const int h = n >> 7, dd = n & 127; return dd < 64 ? h * 64 + dd : 1024 + h * 64 + dd - 64; }
    return n;
}
__device__ __forceinline__ void p0_transpose_item(const float* W, int K, int N, const float* g, bf16* WT, int mode, LAS float* scr, int item, int lane) {
    const int nblk = N / 32, kb = item / nblk, nb = item % nblk, k0 = 64 * kb, n0 = 32 * nb;
#pragma unroll 8
    for (int i = 0; i < 32; ++i) { const int kk = 2 * i + (lane >> 5); float v = W[(size_t)(k0 + kk) * N + n0 + (lane & 31)]; if (g) v *= g[k0 + kk]; scr[kk * 33 + (lane & 31)] = v; }
    LDS_WAIT(); asm volatile("" ::: "memory");
    const int c = lane & 7;
#pragma unroll
    for (int j = 0; j < 4; ++j) { const int n = (lane >> 3) + 8 * j; const LAS float* s = scr + (8 * c) * 33 + n;
        v4u o; o.x = pk2(s[0 * 33], s[1 * 33]); o.y = pk2(s[2 * 33], s[3 * 33]); o.z = pk2(s[4 * 33], s[5 * 33]); o.w = pk2(s[6 * 33], s[7 * 33]);
        *(GAS v4u*)(WT + (size_t)prow(mode, n0 + n) * K + k0 + 8 * c) = o; }
    LDS_WAIT(); asm volatile("" ::: "memory");
}

__global__ void __launch_bounds__(NWAVES * 64, 2) mk_fwd(Args args) {
    extern __shared__ __attribute__((aligned(16))) unsigned char lds[];
    LAS unsigned char* ldsl = (LAS unsigned char*)lds;
    volatile LAS unsigned* MISC = (volatile LAS unsigned*)(ldsl + MISC_OFF);
    const int tid = threadIdx.x, lane = tid & 63, wave = __builtin_amdgcn_readfirstlane(tid >> 6);
    const int G = gridDim.x; const int bx = blockIdx.x; const int vcu = (G % 8 == 0) ? (bx % 8) * (G / 8) + bx / 8 : bx;
    unsigned char* ws = args.ws; gu32* ctl = (gu32*)(ws + WS_CTL);
    const float* x = args.in[0]; const float* g_mix = args.in[1]; const float* g_mlp = args.in[2]; const float* w_in = args.in[3]; const float* gq = args.in[4]; const float* gk = args.in[5];
    const float* w_out = args.in[6]; const float* relb = args.in[7]; const float* w_down = args.in[8]; const float* gqn = args.in[9]; const float* gkvn = args.in[10]; const float* w_uq = args.in[11];
    const float* w_ukv = args.in[12]; const float* w_cout = args.in[13]; const float* w1 = args.in[14]; const float* w2 = args.in[15]; const float* g_fin = args.in[16];
    float* H = args.out;
    float* tab = (float*)(ws + WS_TAB); const float* cosA = tab; const float* sinA = tab + 2048 * 32; const float* cosC = tab + 2 * 2048 * 32; const float* sinC = cosC + 2048 * 16;
    float* SS = (float*)(ws + WS_SS); float* SSQ = SS + (size_t)M * 16; float* SSKV = SSQ + (size_t)M * 4;
    bf16* XN = (bf16*)(ws + WS_XN); bf16* PROJ = (bf16*)(ws + WS_PROJ); bf16* OAB = (bf16*)(ws + WS_OAB); bf16* ACT = (bf16*)(ws + WS_ACT);
    bf16* QN = (bf16*)(ws + WS_QN); bf16* QR = (bf16*)(ws + WS_QR); bf16* KN = (bf16*)(ws + WS_KN); bf16* VC = (bf16*)(ws + WS_VC); bf16* OC = (bf16*)(ws + WS_OC);
    bf16* CQ = (bf16*)(ws + WS_CQ); bf16* CKV = (bf16*)(ws + WS_CKV); bf16* KR = (bf16*)(ws + WS_KR);
    bf16* Wt_in = (bf16*)(ws + WS_W_IN); bf16* Wt_out = (bf16*)(ws + WS_W_OUT); bf16* Wt_cout = (bf16*)(ws + WS_W_COUT); bf16* Wt_down = (bf16*)(ws + WS_W_DOWN); bf16* Wt_uq = (bf16*)(ws + WS_W_UQ);
    bf16* Wt_ukv = (bf16*)(ws + WS_W_UKV); bf16* Wt_1a = (bf16*)(ws + WS_W1_0); bf16* Wt_1b = (bf16*)(ws + WS_W1_1); bf16* Wt_2a = (bf16*)(ws + WS_W2_0); bf16* Wt_2b = (bf16*)(ws + WS_W2_1);

    for (int u = tid; u < (LDS_BYTES - LDSCTL_OFF) / 4; u += NWAVES * 64) ((LAS unsigned*)(ldsl + LDSCTL_OFF))[u] = 0u;
    __syncthreads();
    XcdBarrier bar; bar.bar = (unsigned*)(ctl + CW_BAR); bar.x = 0; bar.st = nullptr;
    if (N_LAUNCHES == 1) bar = xcd_barrier_post((unsigned*)(ctl + CW_BAR), MISC + 8);
    const int lo = args.ph_lo, hi = args.ph_hi;
#ifndef MK_PHASE_MASK
#define MK_PHASE_MASK 0x1fff
#endif
#define IN(k) (((MK_PHASE_MASK >> (k)) & 1) && lo <= (k) && (k) < hi)
#define SEAM(k) do { if (IN(k) && IN((k) + 1)) xcd_barrier(bar); } while (0)
    const int gw = vcu * NWAVES + wave, NGW = G * NWAVES;

    if (IN(0)) {
        LAS float* scr = (LAS float*)(ldsl + wave * 16384);
        constexpr int I_IN = 16 * 72, I_SQ = 16 * 32, I_W1 = 16 * 128, I_W2 = 64 * 32, I_DN = 16 * 13, I_UQ = 4 * 48, I_UKV = 2 * 64;
        constexpr int NITEMS = I_IN + 2 * I_SQ + 2 * I_W1 + 2 * I_W2 + I_DN + I_UQ + I_UKV;
        for (int it = gw; it < NITEMS; it += NGW) {
            int r = it;
            if (r < I_W1) { p0_transpose_item(w1, DM, FF, g_mlp, Wt_1a, 0, scr, r, lane); continue; } r -= I_W1;
            if (r < I_W1) { p0_transpose_item(w1 + (size_t)DM * FF, DM, FF, g_mlp + DM, Wt_1b, 0, scr, r, lane); continue; } r -= I_W1;
            if (r < I_W2) { p0_transpose_item(w2, FF, DM, nullptr, Wt_2a, 0, scr, r, lane); continue; } r -= I_W2;
            if (r < I_W2) { p0_transpose_item(w2 + (size_t)FF * DM, FF, DM, nullptr, Wt_2b, 0, scr, r, lane); continue; } r -= I_W2;
            if (r < I_IN) { p0_transpose_item(w_in, DM, NPROJ, g_mix, Wt_in, 1, scr, r, lane); continue; } r -= I_IN;
            if (r < I_SQ) { p0_transpose_item(w_out, DM, DM, nullptr, Wt_out, 0, scr, r, lane); continue; } r -= I_SQ;
            if (r < I_SQ) { p0_transpose_item(w_cout, DM, DM, nullptr, Wt_cout, 0, scr, r, lane); continue; } r -= I_SQ;
            if (r < I_DN) { p0_transpose_item(w_down, DM, CDOWN, g_mix + DM, Wt_down, 0, scr, r, lane); continue; } r -= I_DN;
            if (r < I_UQ) { p0_transpose_item(w_uq, 256, 1536, gqn, Wt_uq, 2, scr, r, lane); continue; } r -= I_UQ;
            p0_transpose_item(w_ukv, 128, 2048, gkvn, Wt_ukv, 3, scr, r, lane);
        }
        for (int i = gw * 64 + lane; i < 96 * 128; i += NGW * 64) ((GAS v4u*)(Wt_down + (size_t)CDOWN * DM))[i] = (v4u){0u, 0u, 0u, 0u};
        for (int m = gw; m < M; m += NGW) {
            const GAS f32x4* xr = (const GAS f32x4*)(x + (size_t)m * DM) + lane; f32x4 v[4]; float s = 0.f;
#pragma unroll
            for (int j = 0; j < 4; ++j) { v[j] = xr[64 * j]; s += (v[j].x * v[j].x + v[j].y * v[j].y) + (v[j].z * v[j].z + v[j].w * v[j].w); }
            s = wave_sum(s);
            GAS unsigned long long* o8 = (GAS unsigned long long*)(XN + (size_t)m * DM) + lane;
#pragma unroll
            for (int j = 0; j < 4; ++j) o8[64 * j] = (unsigned long long)pk2(v[j].x, v[j].y) | ((unsigned long long)pk2(v[j].z, v[j].w) << 32);
            if (lane < 16) SS[(size_t)m * 16 + lane] = lane == 0 ? s : 0.f;
        }
        for (int i = gw * 64 + lane; i < 2048 * 32; i += NGW * 64) {
            { const int t = i / 32, j = i % 32; const int p = (j < 16) ? (t / 64) : (t % 64); const double inv = pow(10000.0, -(double)(2 * (j & 15)) / 32.0), a = (double)p * inv; tab[i] = (float)cos(a); tab[2048 * 32 + i] = (float)sin(a); }
            if (i < 2048 * 16) { const int t = i / 16, j = i % 16; const double inv = pow(10000.0, -(double)(2 * j) / 32.0), a = (double)t * inv; tab[2 * 2048 * 32 + i] = (float)cos(a); tab[2 * 2048 * 32 + 2048 * 16 + i] = (float)sin(a); }
        }
    }
    SEAM(0);
    if (IN(1)) { pg8::Gemm g{XN, Wt_in, M, NPROJ, DM}; pg8::StaticOrder S; S.init(M, NPROJ, G, bx);
        pg8::EpiInProj E{SS, PROJ, gq, gk, cosA, sinA};
        pg8::gemm_phase<pg8::EpiInProj, pg8::StaticOrder, true, true>(ldsl, g, S, E); }
    SEAM(1);
    if (IN(2)) {
#ifndef MK_SKIP_GQA
        for (int i = 0; i < 2; ++i) { const int id = vcu * 2 + i, qb = id & 7, h = (id >> 3) & 7, b = id >> 6; if (id >= 512) break;
            const bf16* Qp = PROJ + ((size_t)b * SEQ + qb * 256) * NPROJ + h * 64; const bf16* Kp = PROJ + (size_t)b * SEQ * NPROJ + 512 + (h >> 2) * 64;
            attn::dense_unit<64>(Qp, NPROJ, nullptr, 0, Kp, NPROJ, nullptr, 0, Kp + 128, NPROJ, OAB + ((size_t)b * SEQ + qb * 256) * DM + h * 64, DM, SEQ, (char*)lds); }
#endif
        __syncthreads();
#ifndef MK_SKIP_DIL
        for (int i = 0; i < 2; ++i) { const int id = vcu * 2 + i, sb = id & 7, h = (id >> 3) & 7, b = id >> 6; if (id >= 512) break;
            dil::unit(PROJ, OAB, relb, &BUCKET[0][0], b, h, sb, (char*)lds); }
#endif
    }
    SEAM(2);
    if (IN(3)) { pg8::Gemm g{OAB, Wt_out, M, DM, DM}; pg8::StaticOrder S; S.init(M, DM, G, bx);
        pg8::EpiResid E{x, H, XN, SS};
        pg8::gemm_phase<pg8::EpiResid, pg8::StaticOrder, true, true>(ldsl, g, S, E); }
    SEAM(3);
    if (IN(4)) { pg8::Gemm g{XN, Wt_1a, M, FF, DM}; pg8::StaticOrder S; S.init(M, FF, G, bx);
        pg8::EpiAct E{SS, ACT};
        pg8::gemm_phase<pg8::EpiAct, pg8::StaticOrder, true, true>(ldsl, g, S, E); }
    SEAM(4);
    if (IN(5)) { pg8::Gemm g{ACT, Wt_2a, M, DM, FF}; pg8::StaticOrder S; S.init(M, DM, G, bx);
        pg8::EpiResid E{H, H, XN, SS};
        pg8::gemm_phase<pg8::EpiResid, pg8::StaticOrder, true, true>(ldsl, g, S, E); }
    SEAM(5);
    if (IN(6)) { pg8::Gemm g{XN, Wt_down, M, 512, DM}; pg8::StaticOrder S; S.init(M, 512, G, bx);
        pg8::EpiDown E{SS, CQ, CKV, KR, SSQ, SSKV, cosC, sinC};
        pg8::gemm_phase<pg8::EpiDown, pg8::StaticOrder, true, true>(ldsl, g, S, E); }
    SEAM(6);
    if (IN(7)) {
#ifndef MK_SKIP_UPQ
        { pg8::Gemm g{CQ, Wt_uq, M, 1536, 256}; pg8::StaticOrder S; S.init(M, 1536, G, bx);
          pg8::EpiUpQ E{SSQ, QN, QR, cosC, sinC};
          pg8::gemm_phase<pg8::EpiUpQ, pg8::StaticOrder, true, true>(ldsl, g, S, E); }
#endif
#ifndef MK_SKIP_UPKV
        { pg8::Gemm g{CKV, Wt_ukv, M, 2048, 128}; pg8::StaticOrder S; S.init(M, 2048, G, G - 1 - bx);
          pg8::EpiUpKV E{SSKV, KN, VC};
          pg8::gemm_phase<pg8::EpiUpKV, pg8::StaticOrder, true, true>(ldsl, g, S, E); }
#endif
    }
    SEAM(7);
    if (IN(8)) {
        for (int i = 0; i < 4; ++i) { const int id = vcu * 4 + i, qb = id & 7, h = (id >> 3) & 15, b = id >> 7; if (id >= 1024) break;
            const size_t q0 = (size_t)b * SEQ + qb * 256, k0 = (size_t)b * SEQ;
            attn::dense_unit<96>(QN + q0 * 1024 + h * 64, 1024, QR + q0 * 512 + h * 32, 512, KN + k0 * 1024 + h * 64, 1024, KR + k0 * 32, 32, VC + k0 * 1024 + h * 64, 1024, OC + q0 * 1024 + h * 64, 1024, SEQ, (char*)lds); }
    }
    SEAM(8);
    if (IN(9)) { pg8::Gemm g{OC, Wt_cout, M, DM, DM}; pg8::StaticOrder S; S.init(M, DM, G, bx);
        pg8::EpiResid E{H, H, XN, SS};
        pg8::gemm_phase<pg8::EpiResid, pg8::StaticOrder, true, true>(ldsl, g, S, E); }
    SEAM(9);
    if (IN(10)) { pg8::Gemm g{XN, Wt_1b, M, FF, DM}; pg8::StaticOrder S; S.init(M, FF, G, bx);
        pg8::EpiAct E{SS, ACT};
        pg8::gemm_phase<pg8::EpiAct, pg8::StaticOrder, true, true>(ldsl, g, S, E); }
    SEAM(10);
    if (IN(11)) { pg8::Gemm g{ACT, Wt_2b, M, DM, FF}; pg8::StaticOrder S; S.init(M, DM, G, bx);
        pg8::EpiResid E{H, H, XN, SS};
        pg8::gemm_phase<pg8::EpiResid, pg8::StaticOrder, true, true>(ldsl, g, S, E); }
    SEAM(11);
    if (IN(12)) {
        for (int m = gw; m < M; m += NGW) {
            GAS f32x4* hr = (GAS f32x4*)(H + (size_t)m * DM) + lane; const GAS f32x4* gr = (const GAS f32x4*)g_fin + lane; f32x4 v[4];
#pragma unroll
            for (int j = 0; j < 4; ++j) v[j] = hr[64 * j];
            const GAS f32x4* sp = (const GAS f32x4*)(SS + (size_t)m * 16); const f32x4 a = sp[0], b = sp[1], c = sp[2], d = sp[3];
            const float s = ((a.x + a.y) + (a.z + a.w)) + ((b.x + b.y) + (b.z + b.w)) + ((c.x + c.y) + (c.z + c.w)) + ((d.x + d.y) + (d.z + d.w));
            const float r = rsqrtf(s * (1.0f / 1024.0f) + EPS);
#pragma unroll
            for (int j = 0; j < 4; ++j) hr[64 * j] = v[j] * r * gr[64 * j];
        }
    }
#undef IN
#undef SEAM
}


static void launch_naive_phase(int p, void* const* d_in, float* H, unsigned char* ws, hipStream_t stream) {
    const float* x = (const float*)d_in[0]; const float* g_mix = (const float*)d_in[1]; const float* g_mlp = (const float*)d_in[2]; const float* w_in = (const float*)d_in[3];
    const float* gq = (const float*)d_in[4]; const float* gk = (const float*)d_in[5]; const float* w_out = (const float*)d_in[6]; const float* relb = (const float*)d_in[7];
    const float* w_down = (const float*)d_in[8]; const float* gqn = (const float*)d_in[9]; const float* gkvn = (const float*)d_in[10]; const float* w_uq = (const float*)d_in[11];
    const float* w_ukv = (const float*)d_in[12]; const float* w_cout = (const float*)d_in[13]; const float* w1 = (const float*)d_in[14]; const float* w2 = (const float*)d_in[15];
    const float* g_fin = (const float*)d_in[16];
    float* tab = (float*)(ws + WS_TAB); Tabs T{tab, tab + 2048 * 32, tab + 2 * 2048 * 32, tab + 2 * 2048 * 32 + 2048 * 16};
    float* SS = (float*)(ws + WS_SS); float* SSQ = SS + (size_t)M * 16; float* SSKV = SSQ + (size_t)M * 4;
    bf16* XN = (bf16*)(ws + WS_XN); bf16* PROJ = (bf16*)(ws + WS_PROJ); bf16* OAB = (bf16*)(ws + WS_OAB); bf16* ACT = (bf16*)(ws + WS_ACT);
    bf16* QN = (bf16*)(ws + WS_QN); bf16* QR = (bf16*)(ws + WS_QR); bf16* KN = (bf16*)(ws + WS_KN); bf16* VC = (bf16*)(ws + WS_VC); bf16* OC = (bf16*)(ws + WS_OC);
    bf16* CQ = (bf16*)(ws + WS_CQ); bf16* CKV = (bf16*)(ws + WS_CKV); bf16* KR = (bf16*)(ws + WS_KR);
    switch (p) {
    case 0: n_tables<<<(2048 * 32 + 255) / 256, 256, 0, stream>>>(tab); n_x_to_bf16<<<M / 4, 256, 0, stream>>>(x, XN, SS); break;
    case 1: n_gemm<NEpiInProj><<<dim3(NPROJ / 64, M / 64), 256, 0, stream>>>(XN, DM, w_in, NPROJ, g_mix, DM, NEpiInProj{SS, PROJ, gq, gk, T}); break;
    case 2: n_attn_gqa<<<dim3(SEQ / 256, 8, BATCH), 256, 0, stream>>>(PROJ, OAB); n_attn_dil<<<dim3(SEQ / 256, 8, BATCH), 256, 0, stream>>>(PROJ, relb, OAB); break;
    case 3: n_gemm<NEpiResid><<<dim3(DM / 64, M / 64), 256, 0, stream>>>(OAB, DM, w_out, DM, nullptr, DM, NEpiResid{x, H, XN, SS}); break;
    case 4: n_gemm<NEpiAct><<<dim3(FF / 64, M / 64), 256, 0, stream>>>(XN, DM, w1, FF, g_mlp, DM, NEpiAct{SS, ACT}); break;
    case 5: n_gemm<NEpiResid><<<dim3(DM / 64, M / 64), 256, 0, stream>>>(ACT, FF, w2, DM, nullptr, FF, NEpiResid{H, H, XN, SS}); break;
    case 6: n_gemm<NEpiDown><<<dim3(7, M / 64), 256, 0, stream>>>(XN, DM, w_down, CDOWN, g_mix + DM, DM, NEpiDown{SS, CQ, CKV, KR, SSQ, SSKV, T}); break;
    case 7: n_gemm<NEpiUpQ><<<dim3(24, M / 64), 256, 0, stream>>>(CQ, 256, w_uq, 1536, gqn, 256, NEpiUpQ{SSQ, QN, QR, T});
            n_gemm<NEpiUpKV><<<dim3(32, M / 64), 256, 0, stream>>>(CKV, 128, w_ukv, 2048, gkvn, 128, NEpiUpKV{SSKV, KN, VC}); break;
    case 8: n_attn_mla<<<dim3(SEQ / 256, 16, BATCH), 256, 0, stream>>>(QN, QR, KN, KR, VC, OC); break;
    case 9: n_gemm<NEpiResid><<<dim3(DM / 64, M / 64), 256, 0, stream>>>(OC, DM, w_cout, DM, nullptr, DM, NEpiResid{H, H, XN, SS}); break;
    case 10: n_gemm<NEpiAct><<<dim3(FF / 64, M / 64), 256, 0, stream>>>(XN, DM, w1 + (size_t)DM * FF, FF, g_mlp + DM, DM, NEpiAct{SS, ACT}); break;
    case 11: n_gemm<NEpiResid><<<dim3(DM / 64, M / 64), 256, 0, stream>>>(ACT, FF, w2 + (size_t)FF * DM, DM, nullptr, FF, NEpiResid{H, H, XN, SS}); break;
    default: n_final<<<M / 4, 256, 0, stream>>>(H, g_fin); break;
    }
}
extern "C" void kernel_launch(void* const* d_in, const int* in_sizes, int n_in, void* d_out, int out_size, void* d_ws, size_t ws_size, hipStream_t stream) {
    static int grid = 0;
    if (grid == 0) {
        if (n_in != 17 || in_sizes[0] != M * DM || out_size != M * DM || ws_size < WS_END) { fprintf(stderr, "kernel_launch: unexpected shapes n_in %d out %d ws %zu; nothing launched\n", n_in, out_size, ws_size); grid = -1; return; }
        int dev = 0, cus = 0;
        if (hipGetDevice(&dev) != hipSuccess || hipDeviceGetAttribute(&cus, hipDeviceAttributeMultiprocessorCount, dev) != hipSuccess) { fprintf(stderr, "kernel_launch: device query failed\n"); grid = -1; return; }
        if (hipFuncSetAttribute((const void*)mk_fwd, hipFuncAttributeMaxDynamicSharedMemorySize, LDS_BYTES) != hipSuccess) { fprintf(stderr, "kernel_launch: hipFuncSetAttribute failed\n"); grid = -1; return; }
        int per_cu = 0;
        if (hipOccupancyMaxActiveBlocksPerMultiprocessor(&per_cu, (const void*)mk_fwd, NWAVES * 64, LDS_BYTES) != hipSuccess || per_cu < 1) fprintf(stderr, "kernel_launch: note: occupancy query reports %d blocks per CU\n", per_cu);
        (void)hipGetLastError();
        grid = cus;
    }
    if (grid < 0) return;
    (void)hipMemsetAsync((char*)d_ws + WS_CTL, 0, CTL_ZERO_BYTES, stream);
    Args a{};
    for (int i = 0; i < 17; ++i) a.in[i] = (const float*)d_in[i];
    a.out = (float*)d_out; a.ws = (unsigned char*)d_ws;
    if (N_LAUNCHES == 1) { a.ph_lo = 0; a.ph_hi = NPHASE; hipLaunchKernelGGL(mk_fwd, dim3(grid), dim3(NWAVES * 64), LDS_BYTES, stream, a); }
    else for (int p = 0; p < NPHASE; ++p) {
        if (p == 0 || !((MK_NAIVE_MASK >> p) & 1)) { a.ph_lo = p; a.ph_hi = p + 1; hipLaunchKernelGGL(mk_fwd, dim3(grid), dim3(NWAVES * 64), LDS_BYTES, stream, a); }
        if ((MK_NAIVE_MASK >> p) & 1) launch_naive_phase(p, d_in, (float*)d_out, (unsigned char*)d_ws, stream);
    }
    const hipError_t le = hipPeekAtLastError();
    if (le != hipSuccess) fprintf(stderr, "kernel_launch: launch failed: %s\n", hipGetErrorName(le));
}
```
